# Optimizing an MI355X kernel written in HIP

```python
import math
import jax, jax.numpy as jnp
from jax import lax
import numpy as np

D_MODEL = 2048
BATCH = 16
SEQ = 2048
DEPTH = 1

MEM_LEN = 256
EPS = 1e-6
NSA_HEADS = 8
NSA_KV_GROUPS = 2
NSA_HPG = NSA_HEADS // NSA_KV_GROUPS
HEAD_DIM = 128
CMP_BLOCK = 32
CMP_STRIDE = 16
CMP_HIDDEN = 256
SEL_BLOCK = 64
SEL_TOPK = 16
SEL_LOCAL = 2
FORCE_SCORE = 1e4
WINDOW = 512
WIN_QBLOCK = 128
SEL_QCHUNK = 32
RET_HEADS = 4
RET_QK_DIM = 128
RET_V_DIM = 256
RET_CHUNK = 128
MEM_HEADS = 4
MEM_HEAD_DIM = 256
REL_BUCKETS = 32
REL_MAX_DIST = 128
D_FF = 5632
CONV_WIDTH = 3
NSA_Q = NSA_HEADS * HEAD_DIM
NSA_KV = 3 * 2 * NSA_KV_GROUPS * HEAD_DIM
NSA_GATES = 3 * NSA_HEADS
RET_QK = RET_HEADS * RET_QK_DIM
RET_V = RET_HEADS * RET_V_DIM
MEM_Q = MEM_HEADS * MEM_HEAD_DIM
N_BRANCH = 3
BRANCH_GATES = N_BRANCH * D_MODEL
SPLITS = (NSA_Q, NSA_KV, NSA_GATES, RET_QK, RET_QK, RET_V, RET_V, MEM_Q, BRANCH_GATES)
IN_COLS = NSA_Q + NSA_KV + NSA_GATES + 2 * RET_QK + 2 * RET_V + MEM_Q + BRANCH_GATES

kernel_name = 'hybrid_nsa_retention_memory_block'


def rmsnorm(x, g):
    xf = x.astype(jnp.float32)
    y = xf * lax.rsqrt(jnp.mean(xf * xf, axis=-1, keepdims=True) + EPS)
    return (y * g.astype(jnp.float32)).astype(x.dtype)


def t5_bucket(rel):
    n = jnp.maximum(rel, 0)
    max_exact = REL_BUCKETS // 2
    nf = jnp.maximum(n, 1).astype(jnp.float32)
    large = max_exact + (jnp.log(nf / max_exact) / math.log(REL_MAX_DIST / max_exact)
                         * (REL_BUCKETS - max_exact)).astype(jnp.int32)
    large = jnp.minimum(large, REL_BUCKETS - 1)
    return jnp.where(n < max_exact, n, large)


def masked_softmax(s, mask):
    s = jnp.where(mask, s.astype(jnp.float32), -1e30)
    m = jnp.max(s, axis=-1, keepdims=True)
    p = jnp.where(mask, jnp.exp(s - m), 0.0)
    return p / jnp.maximum(jnp.sum(p, axis=-1, keepdims=True), 1e-30)


def nsa_attention(q, kv, gates, tbl, pe_k, w1_k, w2_k, pe_v, w1_v, w2_v):
    B, G, Hg, S, dh = q.shape
    scale = dh ** -0.5
    t_pos = jnp.arange(S)
    k_c, v_c = kv[0, 0], kv[0, 1]
    k_s, v_s = kv[1, 0], kv[1, 1]
    k_w, v_w = kv[2, 0], kv[2, 1]

    n_cmp = (S - CMP_BLOCK) // CMP_STRIDE + 1
    starts = jnp.arange(n_cmp) * CMP_STRIDE
    tok = starts[:, None] + jnp.arange(CMP_BLOCK)[None, :]

    def compress(t, pe, w1, w2):
        blocks = t[:, :, tok] + pe
        flat = blocks.reshape(B, G, n_cmp, CMP_BLOCK * dh)
        return jax.nn.silu(flat @ w1) @ w2

    kc = compress(k_c, pe_k, w1_k, w2_k)
    vc = compress(v_c, pe_v, w1_v, w2_v)
    rel_c = t_pos[:, None] - (starts + CMP_BLOCK - 1)[None, :]
    s_cmp = jnp.einsum('bghsd,bgnd->bghsn', q, kc) * scale + tbl[:, :, t5_bucket(rel_c)]
    p_cmp = masked_softmax(s_cmp, rel_c >= 0)
    o_cmp = jnp.einsum('bghsn,bgnd->bghsd', p_cmp.astype(vc.dtype), vc)

    n_sel = S // SEL_BLOCK
    top_k = min(SEL_TOPK, n_sel)
    blk_start = jnp.arange(n_sel) * SEL_BLOCK
    overlap = ((starts[:, None] < blk_start[None, :] + SEL_BLOCK)
               & (starts[:, None] + CMP_BLOCK > blk_start[None, :])).astype(jnp.float32)
    imp = jnp.einsum('bghsn,nj->bgsj', p_cmp, overlap)
    cur = (t_pos // SEL_BLOCK)[:, None]
    jb = jnp.arange(n_sel)[None, :]
    forced = (jb == 0) | ((cur - jb >= 0) & (cur - jb < SEL_LOCAL))
    imp = jnp.where(forced, FORCE_SCORE, imp)
    imp = jnp.where(jb <= cur, imp, -1.0)
    _, sel_idx = lax.top_k(imp, top_k)

    n_ch = S // SEL_QCHUNK
    L = top_k * SEL_BLOCK
    q_ch = jnp.moveaxis(q.reshape(B, G, Hg, n_ch, SEL_QCHUNK, dh), 3, 0)
    idx_ch = jnp.moveaxis(sel_idx.reshape(B, G, n_ch, SEL_QCHUNK, top_k), 2, 0)
    offs = jnp.arange(SEL_BLOCK)
    g_i = jnp.arange(G)[None, :, None, None, None]
    h_i = jnp.arange(Hg)[None, None, :, None, None]
    gather = jax.vmap(jax.vmap(lambda src, ix: src[ix]))

    def sel_chunk(args):
        qc, ic, c0 = args
        t = c0 * SEL_QCHUNK + jnp.arange(SEL_QCHUNK)
        pos = (ic[..., None] * SEL_BLOCK + offs).reshape(B, G, SEL_QCHUNK, L)
        ks = gather(k_s, pos)
        vs = gather(v_s, pos)
        rel = t[None, None, :, None] - pos
        bias = tbl[g_i, h_i, t5_bucket(rel)[:, :, None]]
        s = jnp.einsum('bghcd,bgcld->bghcl', qc, ks) * scale + bias
        p = masked_softmax(s, (rel >= 0)[:, :, None])
        return jnp.einsum('bghcl,bgcld->bghcd', p.astype(vs.dtype), vs)

    o_sel = lax.map(sel_chunk, (q_ch, idx_ch, jnp.arange(n_ch)))
    o_sel = jnp.moveaxis(o_sel, 0, 3).reshape(B, G, Hg, S, dh)

    nqb = S // WIN_QBLOCK
    span = WINDOW + WIN_QBLOCK
    kpad = jnp.pad(k_w, ((0, 0), (0, 0), (WINDOW, 0), (0, 0)))
    vpad = jnp.pad(v_w, ((0, 0), (0, 0), (WINDOW, 0), (0, 0)))
    q_wb = jnp.moveaxis(q.reshape(B, G, Hg, nqb, WIN_QBLOCK, dh), 3, 0)
    a = jnp.arange(WIN_QBLOCK)[:, None]
    c = jnp.arange(span)[None, :]
    rel_w = WINDOW + a - c
    bias_w = tbl[:, :, t5_bucket(rel_w)]
    band = (rel_w >= 0) & (rel_w < WINDOW)

    def win_block(args):
        qb, i = args
        kb = lax.dynamic_slice_in_dim(kpad, i * WIN_QBLOCK, span, axis=2)
        vb = lax.dynamic_slice_in_dim(vpad, i * WIN_QBLOCK, span, axis=2)
        valid = band & (i * WIN_QBLOCK - WINDOW + c >= 0)
        s = jnp.einsum('bghqd,bgkd->bghqk', qb, kb) * scale + bias_w
        p = masked_softmax(s, valid)
        return jnp.einsum('bghqk,bgkd->bghqd', p.astype(vb.dtype), vb)

    o_win = lax.map(win_block, (q_wb, jnp.arange(nqb)))
    o_win = jnp.moveaxis(o_win, 0, 3).reshape(B, G, Hg, S, dh)

    o = gates[0] * o_cmp + gates[1] * o_sel + gates[2] * o_win
    return o.transpose(0, 3, 1, 2, 4).reshape(B, S, G * Hg * dh)


def rotate_half(x, cos, sin):
    x1, x2 = jnp.split(x, 2, axis=-1)
    return jnp.concatenate([x1 * cos - x2 * sin, x2 * cos + x1 * sin], axis=-1)


def retention(q, k, v):
    B, H, S, dk = q.shape
    dv = v.shape[-1]
    q = q.astype(jnp.float32)
    k = k.astype(jnp.float32)
    v = v.astype(jnp.float32)
    theta = 1.0 / (10000.0 ** jnp.linspace(0.0, 1.0, dk // 2, dtype=jnp.float32))
    ang = jnp.arange(S, dtype=jnp.float32)[:, None] * theta[None, :]
    cos, sin = jnp.cos(ang), jnp.sin(ang)
    q = rotate_half(q, cos, sin)
    k = rotate_half(k, cos, sin) * (dk ** -0.5)
    gamma = 1.0 - jnp.exp2(-5.0 - jnp.arange(H, dtype=jnp.float32))
    log_g = jnp.log(gamma)
    C = RET_CHUNK
    n = S // C
    j = jnp.arange(C, dtype=jnp.float32)
    diff = j[:, None] - j[None, :]
    dmat = jnp.where(diff >= 0, jnp.exp(jnp.maximum(diff, 0.0)[None] * log_g[:, None, None]), 0.0)
    xi = jnp.exp((j + 1.0)[None, :] * log_g[:, None])
    zeta = jnp.exp((C - 1.0 - j)[None, :] * log_g[:, None])
    g_chunk = jnp.exp(C * log_g)

    def to_chunks(t):
        return jnp.moveaxis(t.reshape(B, H, n, C, t.shape[-1]), 2, 0)

    def step(R, inp):
        qi, ki, vi = inp
        inner = jnp.einsum('bhid,bhmd->bhim', qi, ki) * dmat
        o = (jnp.einsum('bhim,bhme->bhie', inner, vi)
             + jnp.einsum('bhid,bhde->bhie', qi, R) * xi[:, :, None])
        R = R * g_chunk[:, None, None] + jnp.einsum('bhmd,bhme->bhde', ki * zeta[:, :, None], vi)
        return R, o

    R0 = jnp.zeros((B, H, dk, dv), jnp.float32)
    _, o = lax.scan(step, R0, (to_chunks(q), to_chunks(k), to_chunks(v)))
    o = jnp.moveaxis(o, 0, 2).reshape(B, H, S, dv)
    mu = jnp.mean(o, axis=-1, keepdims=True)
    var = jnp.mean(jnp.square(o - mu), axis=-1, keepdims=True)
    o = (o - mu) * lax.rsqrt(var + EPS)
    return o.transpose(0, 2, 1, 3).reshape(B, S, H * dv)


def memory_attention(mq, mk, mv):
    scale = mq.shape[-1] ** -0.5
    s = jnp.einsum('bshd,bmhd->bhsm', mq, mk).astype(jnp.float32) * scale
    p = jax.nn.softmax(s, axis=-1)
    o = jnp.einsum('bhsm,bmhd->bshd', p.astype(mv.dtype), mv)
    return o.reshape(mq.shape[0], mq.shape[1], -1)


def causal_dwconv(u, w, b):
    S = u.shape[1]
    up = jnp.pad(u, ((0, 0), (CONV_WIDTH - 1, 0), (0, 0)))
    y = b
    for kk in range(CONV_WIDTH):
        y = y + w[kk] * up[:, kk:kk + S]
    return y


def setup_inputs(seed: int = 0) -> dict:
    key = jax.random.key(seed)
    ks = jax.random.split(key, 26)
    f32 = jnp.float32

    def nrm(k, shape, scale):
        return jax.random.normal(k, shape, f32) * scale

    def gain(k):
        return 1.0 + 0.05 * jax.random.normal(k, (DEPTH, D_MODEL), f32)

    flat_cmp = CMP_BLOCK * HEAD_DIM
    return {
        'x': nrm(ks[0], (BATCH, SEQ, D_MODEL), 1.0),
        'mem': nrm(ks[1], (BATCH, MEM_LEN, D_MODEL), 1.0),
        'w_in': nrm(ks[2], (DEPTH, D_MODEL, IN_COLS), D_MODEL ** -0.5),
        'cmp_pe_k': nrm(ks[3], (DEPTH, CMP_BLOCK, HEAD_DIM), 0.5),
        'cmp_w1_k': nrm(ks[4], (DEPTH, flat_cmp, CMP_HIDDEN), flat_cmp ** -0.5),
        'cmp_w2_k': nrm(ks[5], (DEPTH, CMP_HIDDEN, HEAD_DIM), CMP_HIDDEN ** -0.5),
        'cmp_pe_v': nrm(ks[6], (DEPTH, CMP_BLOCK, HEAD_DIM), 0.5),
        'cmp_w1_v': nrm(ks[7], (DEPTH, flat_cmp, CMP_HIDDEN), flat_cmp ** -0.5),
        'cmp_w2_v': nrm(ks[8], (DEPTH, CMP_HIDDEN, HEAD_DIM), CMP_HIDDEN ** -0.5),
        'rel_bias': nrm(ks[9], (REL_BUCKETS, NSA_HEADS), 0.5),
        'w_mem_kv': nrm(ks[10], (DEPTH, D_MODEL, 2 * MEM_Q), D_MODEL ** -0.5),
        'w_br_nsa': nrm(ks[11], (DEPTH, NSA_Q, D_MODEL), NSA_Q ** -0.5),
        'w_br_ret': nrm(ks[12], (DEPTH, RET_V, D_MODEL), RET_V ** -0.5),
        'w_br_mem': nrm(ks[13], (DEPTH, MEM_Q, D_MODEL), MEM_Q ** -0.5),
        'w_o': nrm(ks[14], (DEPTH, D_MODEL, D_MODEL), D_MODEL ** -0.5),
        'w_up': nrm(ks[15], (DEPTH, D_MODEL, 2 * D_FF), D_MODEL ** -0.5),
        'conv_w': nrm(ks[16], (DEPTH, CONV_WIDTH, 2 * D_FF), CONV_WIDTH ** -0.5),
        'conv_b': nrm(ks[17], (DEPTH, 2 * D_FF), 0.01),
        'w_down': nrm(ks[18], (DEPTH, D_FF, D_MODEL), D_FF ** -0.5),
        'g_pre_mix': gain(ks[19]),
        'g_post_mix': gain(ks[20]),
        'g_mem': gain(ks[21]),
        'g_pre_ffn': gain(ks[22]),
        'g_post_ffn': gain(ks[23]),
    }


def reference(x, mem, w_in, cmp_pe_k, cmp_w1_k, cmp_w2_k, cmp_pe_v, cmp_w1_v, cmp_w2_v,
              rel_bias, w_mem_kv, w_br_nsa, w_br_ret, w_br_mem, w_o, w_up, conv_w, conv_b,
              w_down, g_pre_mix, g_post_mix, g_mem, g_pre_ffn, g_post_ffn):
    B, S, D = x.shape
    M = mem.shape[1]
    G, Hg, dh = NSA_KV_GROUPS, NSA_HPG, HEAD_DIM
    pts = np.cumsum(np.array(SPLITS))[:-1].tolist()
    tbl = rel_bias.T.reshape(G, Hg, REL_BUCKETS)
    for l in range(DEPTH):
        h = rmsnorm(x, g_pre_mix[l])
        proj = h @ w_in[l]
        nq, nkv, ngate, rq, rk, rv, rg, mq, bg = jnp.split(proj, pts, axis=-1)

        q_a = nq.reshape(B, S, G, Hg, dh).transpose(0, 2, 3, 1, 4)
        kv_a = nkv.reshape(B, S, 3, 2, G, dh).transpose(2, 3, 0, 4, 1, 5)
        gate_a = jax.nn.sigmoid(ngate.reshape(B, S, 3, G, Hg)).transpose(2, 0, 3, 4, 1)[..., None]
        y_a = nsa_attention(q_a, kv_a, gate_a.astype(x.dtype), tbl,
                            cmp_pe_k[l], cmp_w1_k[l], cmp_w2_k[l],
                            cmp_pe_v[l], cmp_w1_v[l], cmp_w2_v[l])

        q_r = rq.reshape(B, S, RET_HEADS, RET_QK_DIM).transpose(0, 2, 1, 3)
        k_r = rk.reshape(B, S, RET_HEADS, RET_QK_DIM).transpose(0, 2, 1, 3)
        v_r = rv.reshape(B, S, RET_HEADS, RET_V_DIM).transpose(0, 2, 1, 3)
        y_b = (retention(q_r, k_r, v_r).astype(x.dtype) * jax.nn.silu(rg))

        mem_n = rmsnorm(mem, g_mem[l])
        mkv = (mem_n @ w_mem_kv[l]).reshape(B, M, 2, MEM_HEADS, MEM_HEAD_DIM)
        y_c = memory_attention(mq.reshape(B, S, MEM_HEADS, MEM_HEAD_DIM),
                               mkv[:, :, 0], mkv[:, :, 1])

        bgate = jax.nn.sigmoid(bg.reshape(B, S, N_BRANCH, D))
        merged = (bgate[:, :, 0] * (y_a @ w_br_nsa[l])
                  + bgate[:, :, 1] * (y_b @ w_br_ret[l])
                  + bgate[:, :, 2] * (y_c @ w_br_mem[l]))
        x = x + rmsnorm(merged @ w_o[l], g_post_mix[l])

        h2 = rmsnorm(x, g_pre_ffn[l])
        u = causal_dwconv(h2 @ w_up[l], conv_w[l], conv_b[l])
        u_gate, u_val = jnp.split(u, 2, axis=-1)
        f = (jax.nn.gelu(u_gate, approximate=True) * u_val) @ w_down[l]
        x = x + rmsnorm(f, g_post_ffn[l])
    return x
```

```cpp
#include <hip/hip_runtime.h>
#include <hip/hip_cooperative_groups.h>
#include <cstdio>
namespace cg = cooperative_groups;

#define LAS __attribute__((address_space(3)))
#define DI __device__ __forceinline__
typedef unsigned short bf16_t;
typedef short bf16x8 __attribute__((ext_vector_type(8)));
typedef short bf16x4 __attribute__((ext_vector_type(4)));
typedef float f32x4 __attribute__((ext_vector_type(4)));
typedef unsigned u32x4 __attribute__((ext_vector_type(4)));
typedef unsigned u32x2 __attribute__((ext_vector_type(2)));

constexpr int DM = 2048, SEQ = 2048, BATCH = 16, MEML = 256;
constexpr int NB = 8, NCHUNK = BATCH / NB, MC = NB * SEQ;
constexpr int IN_COLS = 12824, INP = 13056, DFF = 5632, UPC = 2 * DFF;
constexpr float EPS = 1e-6f, LOG2E_ = 1.4426950408889634f;
constexpr int NT = 512;
constexpr int LDS_PHASE = 141312, LDS_HALO = LDS_PHASE + 64, LDS_BYTES = LDS_HALO + 8192;

constexpr size_t O_WIN  = 0;
constexpr size_t O_WUP  = O_WIN  + (size_t)INP * 2048 * 2;
constexpr size_t O_WDN  = O_WUP  + (size_t)UPC * 2048 * 2;
constexpr size_t O_WO   = O_WDN  + (size_t)2048 * DFF * 2;
constexpr size_t O_WBR  = O_WO   + (size_t)2048 * 2048 * 2;
constexpr size_t O_WMKV = O_WBR  + 3 * (size_t)2048 * 1024 * 2;
constexpr size_t O_WC1  = O_WMKV + (size_t)2048 * 2048 * 2;
constexpr size_t O_WC2  = O_WC1  + 2 * (size_t)256 * 4096 * 2;
constexpr size_t O_PEB  = O_WC2  + 2 * (size_t)256 * 256 * 2;
constexpr size_t O_H    = O_PEB  + 4096 + 256 * 256 * 4;
constexpr size_t O_PROJ = O_H    + (size_t)MC * 2048 * 2;
constexpr size_t O_QA   = O_PROJ;
constexpr size_t O_KC   = O_QA   + (size_t)MC * 1024 * 2;
constexpr size_t O_VC   = O_KC   + (size_t)MC * 256 * 2;
constexpr size_t O_KS   = O_VC   + (size_t)MC * 256 * 2;
constexpr size_t O_KW   = O_KS   + (size_t)MC * 256 * 2;
constexpr size_t O_VST  = O_KW   + (size_t)MC * 256 * 2;
constexpr size_t O_VWT  = O_VST  + (size_t)MC * 256 * 2;
constexpr size_t O_GATE = O_VWT  + (size_t)MC * 256 * 2;
constexpr size_t O_RQ   = O_GATE + (size_t)MC * 24 * 4;
constexpr size_t O_RK   = O_RQ   + (size_t)MC * 512 * 2;
constexpr size_t O_RVT  = O_RK   + (size_t)MC * 512 * 2;
constexpr size_t O_RG   = O_RVT  + (size_t)MC * 1024 * 2;
constexpr size_t O_MQ   = O_RG   + (size_t)MC * 1024 * 2;
constexpr size_t O_BG   = O_MQ   + (size_t)MC * 1024 * 2;
constexpr size_t O_PROJ_END = O_BG + (size_t)MC * 6144 * 2;
constexpr size_t O_U    = O_PROJ;
static_assert(O_U + (size_t)MC * UPC * 2 <= O_PROJ_END, "u overlay");
constexpr size_t O_MEMN = O_PROJ_END;
constexpr size_t O_MK   = O_MEMN + (size_t)NB * 256 * 2048 * 2;
constexpr size_t O_MVT  = O_MK   + (size_t)NB * 256 * 1024 * 2;
constexpr size_t O_H1   = O_MVT  + (size_t)NB * 256 * 1024 * 2;
constexpr size_t O_KCMP = O_H1   + 2 * (size_t)NB * 256 * 256 * 2;
constexpr size_t O_VCMT = O_KCMP + (size_t)NB * 2 * 128 * 128 * 2;
constexpr size_t O_YA   = O_VCMT + (size_t)NB * 2 * 128 * 128 * 2;
constexpr size_t O_YB   = O_YA   + (size_t)MC * 1024 * 2;
constexpr size_t O_YC   = O_YB   + (size_t)MC * 1024 * 2;
constexpr size_t O_MO   = O_YC   + (size_t)MC * 1024 * 2;
constexpr size_t O_ACT  = O_MO   + (size_t)MC * 2048 * 2;
constexpr size_t O_BAR  = O_ACT  + (size_t)MC * DFF * 2;
constexpr size_t O_HU   = O_BAR  + 16384;
constexpr size_t O_HF   = O_HU   + (size_t)64 * 2 * UPC * 4;
constexpr size_t O_END  = O_HF   + (size_t)64 * 2 * UPC * 4;
static_assert(O_END <= ((size_t)1 << 30), "workspace");

struct Params { const float* in[24]; float* out; unsigned char* ws; };
typedef const __attribute__((address_space(4))) Params KP;

typedef float f32x2_ __attribute__((ext_vector_type(2)));
typedef __bf16 bf16x2_ __attribute__((ext_vector_type(2)));
DI unsigned cvt_pk_bf16(float lo, float hi) { const f32x2_ v = {lo, hi}; const bf16x2_ b = __builtin_convertvector(v, bf16x2_); return __builtin_bit_cast(unsigned, b); }
DI float bf2f(unsigned short b) { return __uint_as_float(((unsigned)b) << 16); }
DI void st4(bf16_t* p, f32x4 v) { u32x2 w; w.x = cvt_pk_bf16(v[0], v[1]); w.y = cvt_pk_bf16(v[2], v[3]); *(u32x2*)p = w; }
DI float sigmoidf_(float x) { return __builtin_amdgcn_rcpf(1.0f + __builtin_amdgcn_exp2f(-1.4426950408889634f * x)); }
DI int lane_now() { unsigned z = 0u; asm volatile("" : "+v"(z)); return (int)__builtin_amdgcn_mbcnt_hi(~0u, __builtin_amdgcn_mbcnt_lo(~0u, z)); }
#define TIDX (wv * 64 + lane_now())
DI int opq_v(int x) { asm volatile("" : "+v"(x)); return x; }
DI int opq_s(int x) { asm volatile("" : "+s"(x)); return x; }
DI float shx(float v, int lane, int m) { return __int_as_float(__builtin_amdgcn_ds_bpermute((lane ^ m) << 2, __float_as_int(v))); }
DI float shl(float v, int src) { return __int_as_float(__builtin_amdgcn_ds_bpermute(src << 2, __float_as_int(v))); }
DI float wave_sum(float v, int lane) {
#pragma unroll
    for (int o = 32; o > 0; o >>= 1) v += shx(v, lane, o);
    return v; }

DI unsigned xcc_id() { return (unsigned)__builtin_amdgcn_s_getreg((3 << 11) | 20) & 0xFu; }
DI void grid_barrier(unsigned* w, LAS unsigned* st, int wv) {
    asm volatile("s_waitcnt vmcnt(0) lgkmcnt(0)" ::: "memory");
    __syncthreads();
    if (TIDX == 0) {
        const unsigned xcc = st[0], nloc = st[1], nx = st[2], gen = st[3] + 1u;
        st[3] = gen;
        const unsigned old = __hip_atomic_fetch_add(w + 1024 + 64 * xcc, 1u, __ATOMIC_RELAXED, __HIP_MEMORY_SCOPE_AGENT);
        if (old + 1u == gen * nloc) {
            __builtin_amdgcn_fence(__ATOMIC_RELEASE, "agent");
            asm volatile("s_waitcnt vmcnt(0)" ::: "memory");
            __hip_atomic_fetch_add(w + 2048, 1u, __ATOMIC_RELAXED, __HIP_MEMORY_SCOPE_AGENT);
        }
        while (__hip_atomic_load(w + 2048, __ATOMIC_RELAXED, __HIP_MEMORY_SCOPE_AGENT) < gen * nx) __builtin_amdgcn_s_sleep(2);
        __builtin_amdgcn_fence(__ATOMIC_ACQUIRE, "agent");
        asm volatile("s_waitcnt vmcnt(0)" ::: "memory");
    }
    __syncthreads();
}

namespace pg8 {
constexpr int BM = 256, BK = 64, HALF = 128, HTB = HALF * BK * 2, STAGE_BYTES = 8 * HTB, NXCD = 8, WGM = 8;
DI int lds_byte(int r, int c) { const int st = (r >> 4) * 2 + (c >> 5), rr = r & 15, cc = c & 31, ob = rr * 64 + cc * 2; return st * 1024 + (ob ^ (((ob >> 9) & 1) << 5)); }
DI void stage_rc(int b, int& R, int& C) { const int st = b / 1024, sb = b % 1024, swz = sb ^ (((sb >> 9) & 1) << 5); R = (st >> 1) * 16 + swz / 64; C = (st & 1) * 32 + (swz % 64) / 2; }
DI int perm32(int rho) { const int n = rho >> 4, i = rho & 15; return 8 * (i >> 2) + 4 * n + (i & 3); }
struct Unit { int pm, pn; };
struct Gemm { const bf16_t* A; const bf16_t* Bt; int lda, ldb, M, N, K; };
struct StaticOrder {
    int nM, nN, nwg, G, c;
    DI void init(int M, int N, int G_, int c_) { nM = M / BM; nN = N / BM; nwg = nM * nN; G = G_; c = c_; }
    DI bool next(int i, Unit& u) const {
        const long L = (long)i * G + c; if (L >= nwg) return false;
        int wgid = (int)L; { const int q = nwg / NXCD, r = nwg % NXCD, xcd = wgid % NXCD, off = wgid / NXCD; wgid = (xcd < r ? xcd * (q + 1) : r * (q + 1) + (xcd - r) * q) + off; }
        const int nig = WGM * nN, gid = wgid / nig, fm = gid * WGM, gsz = (nM - fm) < WGM ? (nM - fm) : WGM;
        u.pm = fm + ((wgid % nig) % gsz); u.pn = (wgid % nig) / gsz; return true;
    }
};
template <class Epi>
DI void gemm_phase(LAS unsigned char* lds, const Gemm g, const StaticOrder& S, const Epi& E, int wv) {
    const int tid = opq_v(TIDX), wid = __builtin_amdgcn_readfirstlane(tid >> 6), lane = tid & 63, wr = wid >> 2, wc = wid & 3, fr = lane & 15, fq = lane >> 4;
    const int K = g.K, nt = K / BK;
    unsigned voffA[2], voffB[2];
#pragma unroll
    for (int i = 0; i < 2; ++i) { int R, C; stage_rc(tid * 16 + i * 8192, R, C); const int Rb = Epi::PERM ? ((R & ~31) + perm32(R & 31)) : R;
        voffA[i] = (unsigned)(R * g.lda + C) * 2u; voffB[i] = (unsigned)(Rb * g.ldb + C) * 2u; }
    const size_t kstep = (size_t)(BK * 2);
    const size_t hstepA = (size_t)HALF * g.lda * 2, hstepB = (size_t)HALF * g.ldb * 2;
    const size_t tstepA = 2 * hstepA, tstepB = 2 * hstepB;
    const unsigned ldsw = (unsigned)wid * 1024u;
    const int aoff = lds_byte(wr * 64 + fr, fq * 8), boff = lds_byte(wc * 32 + fr, fq * 8);
#define PG8_SA(b, h) (((b) * 2 + (h)) * HTB)
#define PG8_SB(b, h) ((4 + (b) * 2 + (h)) * HTB)
#define PG8_STAGE(bufoff, gbase, voff) do { _Pragma("unroll") for (int _i = 0; _i < 2; ++_i) \
        __builtin_amdgcn_global_load_lds((const unsigned*)((const char*)(gbase) + (voff)[_i]), (LAS unsigned*)(lds + (bufoff) + ldsw + _i * 8192), 16, 0, 0); } while (0)
#define PG8_LDA(dst, b, h) do { _Pragma("unroll") for (int m = 0; m < 4; ++m) _Pragma("unroll") for (int k = 0; k < 2; ++k) dst[m][k] = *(const LAS bf16x8*)(lds + PG8_SA(b, h) + aoff + m * 2048 + k * 1024); } while (0)
#define PG8_LDB(dst, b, h) do { _Pragma("unroll") for (int n = 0; n < 2; ++n) _Pragma("unroll") for (int k = 0; k < 2; ++k) dst[n][k] = *(const LAS bf16x8*)(lds + PG8_SB(b, h) + boff + n * 2048 + k * 1024); } while (0)
#define PG8_MMA(ai, bj, At, Bt) do { __builtin_amdgcn_s_setprio(1); _Pragma("unroll") for (int m = 0; m < 4; ++m) _Pragma("unroll") for (int n = 0; n < 2; ++n) _Pragma("unroll") for (int k = 0; k < 2; ++k) \
        acc[ai][bj][m][n] = __builtin_amdgcn_mfma_f32_16x16x32_bf16(Bt[n][k], At[m][k], acc[ai][bj][m][n], 0, 0, 0); __builtin_amdgcn_s_setprio(0); } while (0)
#define PG8_WAIT_V(n) asm volatile("s_waitcnt vmcnt(" #n ")" ::: "memory")
#define PG8_WAIT_L(n) asm volatile("s_waitcnt lgkmcnt(" #n ")" ::: "memory")
#define PG8_BAR __builtin_amdgcn_s_barrier()
#define PG8_SCHED __builtin_amdgcn_sched_barrier(0)
    Unit cur, nxt; int ui = 0;
    if (!S.next(0, cur)) return;
    f32x4 acc[2][2][4][2];
#pragma unroll
    for (int a = 0; a < 2; ++a)
#pragma unroll
        for (int b = 0; b < 2; ++b)
#pragma unroll
            for (int m = 0; m < 4; ++m)
#pragma unroll
                for (int n = 0; n < 2; ++n) acc[a][b][m][n] = (f32x4){0.f, 0.f, 0.f, 0.f};
    bf16x8 At[4][2], B0[2][2], B1[2][2];
    const char* cA = (const char*)g.A + (size_t)cur.pm * tstepA; const char* cB = (const char*)g.Bt + (size_t)cur.pn * tstepB;
    PG8_STAGE(PG8_SB(0, 0), cB, voffB); PG8_STAGE(PG8_SA(0, 0), cA, voffA); PG8_STAGE(PG8_SB(0, 1), cB + hstepB, voffB); PG8_STAGE(PG8_SA(0, 1), cA + hstepA, voffA);
    if (wr == 1) PG8_BAR;
    PG8_WAIT_V(4); PG8_BAR;
    PG8_STAGE(PG8_SB(1, 0), cB + kstep, voffB); PG8_STAGE(PG8_SA(1, 0), cA + kstep, voffA); PG8_STAGE(PG8_SB(1, 1), cB + hstepB + kstep, voffB);
    PG8_WAIT_V(6); PG8_BAR;
    for (;;) {
        const bool has_next = S.next(ui + 1, nxt);
        const char* nA = has_next ? (const char*)g.A + (size_t)nxt.pm * tstepA : cA; const char* nB = has_next ? (const char*)g.Bt + (size_t)nxt.pn * tstepB : cB;
        for (int t = 0; t < nt; t += 2) {
            const bool last = (t == nt - 2);
            const char* a1 = cA + (size_t)(t + 1) * kstep;
            const char* a2 = last ? nA : cA + (size_t)(t + 2) * kstep; const char* b2 = last ? nB : cB + (size_t)(t + 2) * kstep;
            const char* a3 = a2 + kstep; const char* b3 = b2 + kstep;
            PG8_LDB(B0, 0, 0); PG8_SCHED; PG8_LDA(At, 0, 0); PG8_STAGE(PG8_SA(1, 1), a1 + hstepA, voffA);
            PG8_WAIT_L(8); PG8_BAR; PG8_WAIT_L(0); PG8_MMA(0, 0, At, B0); PG8_BAR; PG8_SCHED;
            PG8_LDB(B1, 0, 1); PG8_STAGE(PG8_SB(0, 0), b2, voffB);
            PG8_BAR; PG8_WAIT_L(0); PG8_MMA(0, 1, At, B1); PG8_BAR;
            PG8_LDA(At, 0, 1); PG8_STAGE(PG8_SA(0, 0), a2, voffA);
            PG8_BAR; PG8_WAIT_L(0); PG8_MMA(1, 0, At, B0); PG8_BAR; PG8_SCHED;
            PG8_STAGE(PG8_SB(0, 1), b2 + hstepB, voffB);
            PG8_WAIT_V(6); PG8_BAR; PG8_MMA(1, 1, At, B1); PG8_BAR;
            PG8_LDB(B0, 1, 0); PG8_SCHED; PG8_LDA(At, 1, 0); PG8_STAGE(PG8_SA(0, 1), a2 + hstepA, voffA);
            PG8_WAIT_L(8); PG8_BAR; PG8_WAIT_L(0); PG8_MMA(0, 0, At, B0); PG8_BAR; PG8_SCHED;
            PG8_LDB(B1, 1, 1); PG8_STAGE(PG8_SB(1, 0), b3, voffB);
            PG8_BAR; PG8_WAIT_L(0); PG8_MMA(0, 1, At, B1); PG8_BAR;
            PG8_LDA(At, 1, 1); PG8_STAGE(PG8_SA(1, 0), a3, voffA);
            PG8_BAR; PG8_WAIT_L(0); PG8_MMA(1, 0, At, B0); PG8_BAR; PG8_SCHED;
            PG8_STAGE(PG8_SB(1, 1), b3 + hstepB, voffB);
            PG8_WAIT_V(6); PG8_BAR; PG8_MMA(1, 1, At, B1); PG8_BAR;
        }
        E(acc, cur, wr, wc, fr, fq);
        if (!has_next) break;
#pragma unroll
        for (int a = 0; a < 2; ++a)
#pragma unroll
            for (int b = 0; b < 2; ++b)
#pragma unroll
                for (int m = 0; m < 4; ++m)
#pragma unroll
                    for (int n = 0; n < 2; ++n) acc[a][b][m][n] = (f32x4){0.f, 0.f, 0.f, 0.f};
        cur = nxt; cA = nA; cB = nB; ++ui;
    }
    PG8_WAIT_V(0);
    if (wr == 0) PG8_BAR;
    PG8_BAR;
#undef PG8_SA
#undef PG8_SB
#undef PG8_STAGE
#undef PG8_LDA
#undef PG8_LDB
#undef PG8_MMA
#undef PG8_WAIT_V
#undef PG8_WAIT_L
#undef PG8_BAR
#undef PG8_SCHED
}
}
using pg8::Unit;
typedef f32x4 Acc[2][2][4][2];

DI u32x4 pk8(f32x4 a, f32x4 b) { u32x4 w; w[0] = cvt_pk_bf16(a[0], a[1]); w[1] = cvt_pk_bf16(a[2], a[3]); w[2] = cvt_pk_bf16(b[0], b[1]); w[3] = cvt_pk_bf16(b[2], b[3]); return w; }
struct EpiStore {
    static constexpr bool PERM = true;
    bf16_t* O; int ldc;
    DI void operator()(const Acc& acc, const Unit& u, int wr, int wc, int fr, int fq) const {
#pragma unroll
        for (int ai = 0; ai < 2; ++ai)
#pragma unroll
            for (int m = 0; m < 4; ++m) {
                const size_t row = (size_t)u.pm * 256 + ai * 128 + wr * 64 + m * 16 + fr;
#pragma unroll
                for (int bj = 0; bj < 2; ++bj) *(u32x4*)(O + row * ldc + u.pn * 256 + bj * 128 + wc * 32 + fq * 8) = pk8(acc[ai][bj][m][0], acc[ai][bj][m][1]);
            }
    }
};
template <int FIRST> struct EpiMerge {
    static constexpr bool PERM = true;
    bf16_t* O; const bf16_t* gate; int goff;
    DI void operator()(const Acc& acc, const Unit& u, int wr, int wc, int fr, int fq) const {
#pragma unroll
        for (int ai = 0; ai < 2; ++ai)
#pragma unroll
            for (int m = 0; m < 4; ++m) {
                const size_t row = (size_t)u.pm * 256 + ai * 128 + wr * 64 + m * 16 + fr;
#pragma unroll
                for (int bj = 0; bj < 2; ++bj) {
                    const int col = u.pn * 256 + bj * 128 + wc * 32 + fq * 8;
                    const bf16x8 gv = *(const bf16x8*)(gate + row * 6144 + goff + col);
                    f32x4 v0 = acc[ai][bj][m][0], v1 = acc[ai][bj][m][1];
#pragma unroll
                    for (int j = 0; j < 4; ++j) { v0[j] *= bf2f((unsigned short)gv[j]); v1[j] *= bf2f((unsigned short)gv[4 + j]); }
                    if (!FIRST) { const bf16x8 ov = *(const bf16x8*)(O + row * 2048 + col);
#pragma unroll
                        for (int j = 0; j < 4; ++j) { v0[j] += bf2f((unsigned short)ov[j]); v1[j] += bf2f((unsigned short)ov[4 + j]); } }
                    *(u32x4*)(O + row * 2048 + col) = pk8(v0, v1);
                }
            }
    }
};
#define ROWLOOP _Pragma("unroll") for (int ai = 0; ai < 2; ++ai) _Pragma("unroll") for (int m = 0; m < 4; ++m)
#define BJLOOP _Pragma("unroll") for (int bj = 0; bj < 2; ++bj)
DI bf16_t bf1(float x) { return (bf16_t)(cvt_pk_bf16(x, 0.f) & 0xffffu); }
DI float dppx1(float x) { return __int_as_float(__builtin_amdgcn_update_dpp(0, __float_as_int(x), 0xB1, 0xf, 0xf, false)); }
DI float dppx2(float x) { return __int_as_float(__builtin_amdgcn_update_dpp(0, __float_as_int(x), 0x4E, 0xf, 0xf, false)); }
DI f32x4 quad_transpose(f32x4 v, int l) {
    const bool o1 = (l & 1) != 0, o2 = (l & 2) != 0;
    const float r0 = dppx1(o1 ? v[0] : v[1]), r1 = dppx1(o1 ? v[2] : v[3]);
    if (o1) { v[0] = r0; v[2] = r1; } else { v[1] = r0; v[3] = r1; }
    const float q0 = dppx2(o2 ? v[0] : v[2]), q1 = dppx2(o2 ? v[1] : v[3]);
    if (o2) { v[0] = q0; v[1] = q1; } else { v[2] = q0; v[3] = q1; }
    return v;
}
struct EpiMemKV {
    static constexpr bool PERM = true;
    bf16_t* mk; bf16_t* mvt;
    DI void operator()(const Acc& acc, const Unit& u, int wr, int wc, int fr, int fq) const {
        const int cb8 = wc * 32 + fq * 8;
        ROWLOOP { const int row = u.pm * 256 + ai * 128 + wr * 64 + m * 16 + fr, bl = row >> 8, mm = row & 255;
            BJLOOP { const int col = u.pn * 256 + bj * 128 + cb8;
                if (u.pn < 4) *(u32x4*)(mk + (size_t)row * 1024 + col) = pk8(acc[ai][bj][m][0], acc[ai][bj][m][1]);
                else {
#pragma unroll
                    for (int n = 0; n < 2; ++n)
#pragma unroll
                        for (int j = 0; j < 4; ++j) mvt[((size_t)bl * 1024 + (col - 1024 + n * 4 + j)) * 256 + mm] = bf1(acc[ai][bj][m][n][j]);
                } } }
    }
};
struct EpiC1 {
    static constexpr bool PERM = true;
    bf16_t* O; const float* peb;
    DI void operator()(const Acc& acc, const Unit& u, int wr, int wc, int fr, int fq) const {
        const int cb8 = wc * 32 + fq * 8;
        ROWLOOP { const size_t row = (size_t)u.pm * 256 + ai * 128 + wr * 64 + m * 16 + fr;
            BJLOOP { const int col = bj * 128 + cb8;
                f32x4 v0 = acc[ai][bj][m][0], v1 = acc[ai][bj][m][1];
#pragma unroll
                for (int j = 0; j < 4; ++j) { const float z0 = v0[j] + peb[col + j], z1 = v1[j] + peb[col + 4 + j]; v0[j] = z0 * sigmoidf_(z0); v1[j] = z1 * sigmoidf_(z1); }
                *(u32x4*)(O + row * 256 + col) = pk8(v0, v1); } }
    }
};
template <int ISV> struct EpiC2 {
    static constexpr bool PERM = true;
    bf16_t* O;
    DI void operator()(const Acc& acc, const Unit& u, int wr, int wc, int fr, int fq) const {
        const int cb8 = wc * 32 + fq * 8;
        ROWLOOP { const int row = u.pm * 256 + ai * 128 + wr * 64 + m * 16 + fr, bg = row >> 7, nn = row & 127;
            f32x4 v0 = acc[ai][0][m][0], v1 = acc[ai][0][m][1];
            if (nn == 127) { v0 = (f32x4){0.f, 0.f, 0.f, 0.f}; v1 = v0; }
            if (!ISV) *(u32x4*)(O + (size_t)row * 128 + cb8) = pk8(v0, v1);
            else {
#pragma unroll
                for (int j = 0; j < 4; ++j) { O[((size_t)bg * 128 + cb8 + j) * 128 + nn] = bf1(v0[j]); O[((size_t)bg * 128 + cb8 + 4 + j) * 128 + nn] = bf1(v1[j]); }
            } }
    }
};
struct EpiInProj {
    static constexpr bool PERM = true;
    unsigned char* ws;
    DI void operator()(const Acc& acc, const Unit& u, int wr, int wc, int fr, int fq) const {
        const int pn = u.pn;
        const int rbase = u.pm * 256 + wr * 64 + fr, cb8 = wc * 32 + fq * 8;
        if (pn < 4) {
            bf16_t* const qa = (bf16_t*)(ws + O_QA);
            ROWLOOP { const int row = rbase + ai * 128 + m * 16;
                BJLOOP *(u32x4*)(qa + (size_t)row * 1024 + pn * 256 + bj * 128 + cb8) = pk8(acc[ai][bj][m][0], acc[ai][bj][m][1]); }
        } else if (pn < 10) {
            const int br = (pn - 4) >> 1, isv = (pn - 4) & 1;
            if (!isv || br == 0) {
                bf16_t* base = (bf16_t*)(ws + (isv ? O_VC : (br == 0 ? O_KC : (br == 1 ? O_KS : O_KW))));
                ROWLOOP { const int row = rbase + ai * 128 + m * 16, bl = row >> 11, s = row & 2047;
                    BJLOOP *(u32x4*)(base + ((size_t)(bl * 2 + bj) * 2048 + s) * 128 + cb8) = pk8(acc[ai][bj][m][0], acc[ai][bj][m][1]); }
            } else {
                bf16_t* base = (bf16_t*)(ws + (br == 1 ? O_VST : O_VWT));
                const int l4 = fr & 3;
                ROWLOOP { const int row = rbase + ai * 128 + m * 16, bl = row >> 11, s4 = (row & 2047) - l4;
                    BJLOOP {
#pragma unroll
                        for (int n = 0; n < 2; ++n) st4(base + ((size_t)(bl * 2 + bj) * 128 + cb8 + n * 4 + l4) * 2048 + s4, quad_transpose(acc[ai][bj][m][n], l4)); } }
            }
        } else if (pn < 14) {
            const int isk = pn >= 12;
            bf16_t* base = (bf16_t*)(ws + (isk ? O_RK : O_RQ));
            const float sc = isk ? 0.08838834764831845f : 1.0f;
            float th[4];
#pragma unroll
            for (int j = 0; j < 4; ++j) th[j] = 1.0f / exp2f(13.287712379549449f * (float)(16 * wc + 4 * fq + j) * (1.0f / 63.0f));
            ROWLOOP { const int row = rbase + ai * 128 + m * 16, s = row & 2047;
                float sn[4], cs[4];
#pragma unroll
                for (int j = 0; j < 4; ++j) {
                    const float a = (float)s * th[j];
                    const float kq = rintf(a * 0.15915494309189535f);
                    float r = fmaf(-kq, 6.28125f, a); r = fmaf(-kq, 1.9353071795864769e-3f, r);
                    sn[j] = __sinf(r); cs[j] = __cosf(r);
                }
                BJLOOP {
                    const int head = ((pn - 10) & 1) * 2 + bj;
                    const f32x4 x1 = acc[ai][bj][m][0], x2 = acc[ai][bj][m][1];
                    f32x4 o1, o2;
#pragma unroll
                    for (int j = 0; j < 4; ++j) { o1[j] = (x1[j] * cs[j] - x2[j] * sn[j]) * sc; o2[j] = (x2[j] * cs[j] + x1[j] * sn[j]) * sc; }
                    *(u32x4*)(base + (size_t)row * 512 + head * 128 + cb8) = pk8(o1, o2);
                } }
        } else if (pn < 18) {
            bf16_t* base = (bf16_t*)(ws + O_RVT);
            const int l4 = fr & 3;
            ROWLOOP { const int row = rbase + ai * 128 + m * 16, bl = row >> 11, s4 = (row & 2047) - l4;
                BJLOOP { const int col = (pn - 14) * 256 + bj * 128 + cb8;
#pragma unroll
                    for (int n = 0; n < 2; ++n) st4(base + ((size_t)bl * 1024 + col + n * 4 + l4) * 2048 + s4, quad_transpose(acc[ai][bj][m][n], l4)); } }
        } else if (pn < 22) {
            bf16_t* base = (bf16_t*)(ws + O_RG);
            ROWLOOP { const int row = rbase + ai * 128 + m * 16;
                BJLOOP { f32x4 v0 = acc[ai][bj][m][0], v1 = acc[ai][bj][m][1];
#pragma unroll
                    for (int j = 0; j < 4; ++j) { v0[j] = v0[j] * sigmoidf_(v0[j]); v1[j] = v1[j] * sigmoidf_(v1[j]); }
                    *(u32x4*)(base + (size_t)row * 1024 + (pn - 18) * 256 + bj * 128 + cb8) = pk8(v0, v1); } }
        } else if (pn < 26) {
            bf16_t* base = (bf16_t*)(ws + O_MQ);
            ROWLOOP { const int row = rbase + ai * 128 + m * 16;
                BJLOOP *(u32x4*)(base + (size_t)row * 1024 + (pn - 22) * 256 + bj * 128 + cb8) = pk8(acc[ai][bj][m][0], acc[ai][bj][m][1]); }
        } else if (pn < 50) {
            bf16_t* base = (bf16_t*)(ws + O_BG);
            ROWLOOP { const int row = rbase + ai * 128 + m * 16;
                BJLOOP { f32x4 v0 = acc[ai][bj][m][0], v1 = acc[ai][bj][m][1];
#pragma unroll
                    for (int j = 0; j < 4; ++j) { v0[j] = sigmoidf_(v0[j]); v1[j] = sigmoidf_(v1[j]); }
                    *(u32x4*)(base + (size_t)row * 6144 + (pn - 26) * 256 + bj * 128 + cb8) = pk8(v0, v1); } }
        } else {
            float* gt = (float*)(ws + O_GATE);
            ROWLOOP { const int row = rbase + ai * 128 + m * 16;
#pragma unroll
                for (int n = 0; n < 2; ++n) { const f32x4 v = acc[ai][0][m][n]; const int col = cb8 + n * 4;
#pragma unroll
                    for (int j = 0; j < 4; ++j) if (col + j < 24) gt[(size_t)row * 24 + col + j] = sigmoidf_(v[j]); } }
        }
    }
};

DI f32x4 bperm4(f32x4 v, int src) { f32x4 r;
#pragma unroll
    for (int j = 0; j < 4; ++j) r[j] = __int_as_float(__builtin_amdgcn_ds_bpermute(src << 2, __float_as_int(v[j]))); return r; }
DI float gelu_tanh(float x) { const float z = 0.7978845608028654f * (x + 0.044715f * x * x * x); return x * sigmoidf_(2.0f * z); }
typedef _Float16 h2_t __attribute__((ext_vector_type(2)));
DI h2_t pkh(float a, float b) { h2_t r; r[0] = (_Float16)a; r[1] = (_Float16)b; return r; }
DI h2_t h2_ror1(h2_t x) { return __builtin_bit_cast(h2_t, __builtin_amdgcn_update_dpp(0, __builtin_bit_cast(int, x), 0x121, 0xf, 0xf, false)); }
DI h2_t h2_ror2(h2_t x) { return __builtin_bit_cast(h2_t, __builtin_amdgcn_update_dpp(0, __builtin_bit_cast(int, x), 0x122, 0xf, 0xf, false)); }
DI h2_t h2_sel(bool c, h2_t a, h2_t b) { return __builtin_bit_cast(h2_t, c ? __builtin_bit_cast(int, a) : __builtin_bit_cast(int, b)); }
struct EpiUpConv {
    static constexpr bool PERM = false;
    bf16_t* act; const float* cw; const float* cb; float* hu; float* hf; LAS float* halo;
    DI void operator()(const Acc& acc, const Unit& u, int wr, int wc, int fr_in, int fq_in) const {
        const int fr = opq_v(fr_in), fq = opq_v(fq_in);
        const int cbase = wc * 32 + fq * 4;
        if (fr >= 14) {
#pragma unroll
            for (int ai = 0; ai < 2; ++ai)
#pragma unroll
                for (int bj = 0; bj < 2; ++bj)
#pragma unroll
                    for (int n = 0; n < 2; ++n) *(LAS f32x4*)(halo + ((2 * ai + wr) * 2 + (fr - 14)) * 256 + bj * 128 + n * 16 + cbase) = acc[ai][bj][3][n];
            if (wr == 1) {
#pragma unroll
                for (int bj = 0; bj < 2; ++bj)
#pragma unroll
                    for (int n = 0; n < 2; ++n) *(f32x4*)(hu + ((size_t)u.pm * 2 + (fr - 14)) * UPC + u.pn * 256 + bj * 128 + n * 16 + cbase) = acc[1][bj][3][n];
            }
        }
        if (wr == 0 && fr < 2) {
#pragma unroll
            for (int bj = 0; bj < 2; ++bj)
#pragma unroll
                for (int n = 0; n < 2; ++n) *(f32x4*)(hf + ((size_t)u.pm * 2 + fr) * UPC + u.pn * 256 + bj * 128 + n * 16 + cbase) = acc[0][bj][0][n];
        }
        asm volatile("s_waitcnt lgkmcnt(0)" ::: "memory");
        __builtin_amdgcn_s_barrier(); asm volatile("" ::: "memory");
        __builtin_amdgcn_s_barrier(); asm volatile("" ::: "memory");
        const bool seqstart = (u.pm & 7) == 0;
        const bool f1 = fr >= 1, f2 = fr >= 2, f0 = fr == 0;
        const h2_t K1 = pkh(-2.3022082f, -2.3022082f), K2 = pkh(-0.10294324f, -0.10294324f), ONE = pkh(1.0f, 1.0f);
#pragma unroll
        for (int n = 0; n < 2; ++n) {
            const int chb = u.pn * 128 + n * 16 + cbase;
            h2_t wg[2][4], wv_[2][4];
#pragma unroll
            for (int jh = 0; jh < 2; ++jh) {
#pragma unroll
                for (int k = 0; k < 3; ++k) { wg[jh][k] = pkh(cw[(size_t)k * UPC + chb + 2 * jh], cw[(size_t)k * UPC + chb + 2 * jh + 1]); wv_[jh][k] = pkh(cw[(size_t)k * UPC + DFF + chb + 2 * jh], cw[(size_t)k * UPC + DFF + chb + 2 * jh + 1]); }
                wg[jh][3] = pkh(cb[chb + 2 * jh], cb[chb + 2 * jh + 1]); wv_[jh][3] = pkh(cb[DFF + chb + 2 * jh], cb[DFF + chb + 2 * jh + 1]);
            }
#pragma unroll
            for (int ai = 0; ai < 2; ++ai) {
                const int q = 2 * ai + wr;
                h2_t p1g[2], p2g[2], p1v[2], p2v[2];
#pragma unroll
                for (int jh = 0; jh < 2; ++jh) { p1g[jh] = pkh(0.f, 0.f); p2g[jh] = p1g[jh]; p1v[jh] = p1g[jh]; p2v[jh] = p1g[jh]; }
                if (q > 0) {
                    const LAS float* hp = halo + ((q - 1) * 2) * 256 + n * 16 + cbase;
                    const f32x4 h2gf = *(const LAS f32x4*)hp, h1gf = *(const LAS f32x4*)(hp + 256), h2vf = *(const LAS f32x4*)(hp + 128), h1vf = *(const LAS f32x4*)(hp + 384);
#pragma unroll
                    for (int jh = 0; jh < 2; ++jh) {
                        const h2_t h2g = pkh(h2gf[2 * jh], h2gf[2 * jh + 1]), h1g = pkh(h1gf[2 * jh], h1gf[2 * jh + 1]), h2v = pkh(h2vf[2 * jh], h2vf[2 * jh + 1]), h1v = pkh(h1vf[2 * jh], h1vf[2 * jh + 1]);
                        p1g[jh] = h1g; p1v[jh] = h1v; p2g[jh] = h2_sel(f0, h2g, h1g); p2v[jh] = h2_sel(f0, h2v, h1v);
                    }
                }
#pragma unroll
                for (int m = 0; m < 4; ++m) {
                    u32x2 w;
#pragma unroll
                    for (int jh = 0; jh < 2; ++jh) {
                        const h2_t xg = pkh(acc[ai][0][m][n][jh * 2], acc[ai][0][m][n][jh * 2 + 1]), xv = pkh(acc[ai][1][m][n][jh * 2], acc[ai][1][m][n][jh * 2 + 1]);
                        const h2_t r1g = h2_ror1(xg), r2g = h2_ror2(xg), r1v = h2_ror1(xv), r2v = h2_ror2(xv);
                        const h2_t a1g = h2_sel(f1, r1g, p1g[jh]), a2g = h2_sel(f2, r2g, p2g[jh]), a1v = h2_sel(f1, r1v, p1v[jh]), a2v = h2_sel(f2, r2v, p2v[jh]);
                        const h2_t yg = wg[jh][3] + wg[jh][0] * a2g + wg[jh][1] * a1g + wg[jh][2] * xg;
                        const h2_t yv = wv_[jh][3] + wv_[jh][0] * a2v + wv_[jh][1] * a1v + wv_[jh][2] * xv;
                        const h2_t arg = yg * (K1 + K2 * (yg * yg));
                        const h2_t d = __builtin_elementwise_exp2(arg) + ONE;
                        h2_t r; r[0] = __builtin_amdgcn_rcph(d[0]); r[1] = __builtin_amdgcn_rcph(d[1]);
                        const h2_t o = (yg * r) * yv;
                        p1g[jh] = r1g; p2g[jh] = r2g; p1v[jh] = r1v; p2v[jh] = r2v;
                        const unsigned pk = cvt_pk_bf16((float)o[0], (float)o[1]);
                        if (jh == 0) w.x = pk; else w.y = pk;
                    }
                    const size_t row = (size_t)u.pm * 256 + ai * 128 + wr * 64 + m * 16 + fr;
                    if (!(q == 0 && m == 0 && fr < 2 && !seqstart)) *(u32x2*)(act + row * DFF + chb) = w;
                }
            }
        }
    }
};
DI void conv_fixup(const float* hu, const float* hf, const float* cw, const float* cb, bf16_t* act, int wv) {
    constexpr int CG4 = DFF / 4;
    for (int task = opq_s(blockIdx.x) * NT + opq_v(TIDX); task < (MC / 256) * CG4; task += gridDim.x * NT) {
        const int cgp = task % CG4, pm = task / CG4;
        if ((pm & 7) == 0) continue;
        const int ch = cgp * 4, colg = 256 * (ch >> 7) + (ch & 127);
        f32x4 y0[2], y1[2];
#pragma unroll
        for (int hv = 0; hv < 2; ++hv) {
            const int col = colg + 128 * hv, cc = ch + hv * DFF;
            const f32x4 a0 = *(const f32x4*)(hu + ((size_t)(pm - 1) * 2 + 0) * UPC + col), a1 = *(const f32x4*)(hu + ((size_t)(pm - 1) * 2 + 1) * UPC + col);
            const f32x4 f0 = *(const f32x4*)(hf + ((size_t)pm * 2 + 0) * UPC + col), f1 = *(const f32x4*)(hf + ((size_t)pm * 2 + 1) * UPC + col);
            const f32x4 w0 = *(const f32x4*)(cw + cc), w1 = *(const f32x4*)(cw + UPC + cc), w2 = *(const f32x4*)(cw + 2 * UPC + cc), b = *(const f32x4*)(cb + cc);
            y0[hv] = b + w0 * a0 + w1 * a1 + w2 * f0;
            y1[hv] = b + w0 * a1 + w1 * f0 + w2 * f1;
        }
        f32x4 o0, o1;
#pragma unroll
        for (int j = 0; j < 4; ++j) { o0[j] = gelu_tanh(y0[0][j]) * y0[1][j]; o1[j] = gelu_tanh(y1[0][j]) * y1[1][j]; }
        st4(act + ((size_t)pm * 256 + 0) * DFF + ch, o0);
        st4(act + ((size_t)pm * 256 + 1) * DFF + ch, o1);
    }
}

constexpr int A_KS = 0, A_VT = 34816;
constexpr int N_STG = 35840, N_K = 0, N_V = 17408;
constexpr int A_BIAS = 2 * N_STG, A_PART = A_BIAS + 3136, A_EDGE = A_PART + 16384, A_SELM = A_EDGE + 16384;
constexpr int R_STG = 54272, R_K = 0, R_V = 17408;
static_assert(2 * R_STG <= LDS_PHASE, "retention LDS");
static_assert(A_SELM + 256 <= LDS_PHASE, "attention LDS");

template <int ROWBYTES, int NROWS>
DI void g2r(u32x4 (&r)[(ROWBYTES / 16) * NROWS / NT], const bf16_t* src, size_t src_stride, int tid) {
    constexpr int CPR = ROWBYTES / 16, N = CPR * NROWS / NT;
    static_assert(CPR * NROWS % NT == 0, "tile chunks");
#pragma unroll
    for (int i = 0; i < N; ++i) { const int c = i * NT + tid, rr = c / CPR, cc = c % CPR; r[i] = *(const u32x4*)((const char*)(src + (size_t)rr * src_stride) + cc * 16); }
}
template <int ROWBYTES, int NROWS, int LSTRIDE>
DI void r2l(const u32x4 (&r)[(ROWBYTES / 16) * NROWS / NT], LAS unsigned char* dst, int tid) {
    constexpr int CPR = ROWBYTES / 16, N = CPR * NROWS / NT;
#pragma unroll
    for (int i = 0; i < N; ++i) { const int c = i * NT + tid, rr = c / CPR, cc = c % CPR; *(LAS u32x4*)(dst + rr * LSTRIDE + cc * 16) = r[i]; }
}
template <int DQK>
DI void qk_tile(const LAS unsigned char* Ks, int fr, int fq, const bf16x8 (&qf)[DQK / 32], f32x4 (&s)[4]) {
    constexpr int KSTR = (DQK + 8) * 2, NK = DQK / 32;
    const LAS unsigned char* base = Ks + fr * KSTR + fq * 16;
#pragma unroll
    for (int nt = 0; nt < 4; ++nt) s[nt] = (f32x4){0.f, 0.f, 0.f, 0.f};
#pragma unroll
    for (int h = 0; h < NK / 4; ++h) {
        bf16x8 kf[4][4];
#pragma unroll
        for (int nt = 0; nt < 4; ++nt)
#pragma unroll
            for (int kk = 0; kk < 4; ++kk) kf[nt][kk] = *(const LAS bf16x8*)(base + nt * 16 * KSTR + (h * 4 + kk) * 64);
#pragma unroll
        for (int kk = 0; kk < 4; ++kk)
#pragma unroll
            for (int nt = 0; nt < 4; ++nt) s[nt] = __builtin_amdgcn_mfma_f32_16x16x32_bf16(kf[nt][kk], qf[h * 4 + kk], s[nt], 0, 0, 0);
    }
}
template <int DV, int VSTR>
DI void pv_tile(const LAS unsigned char* Vt, int fr, int fq, const f32x4 (&p)[4], f32x4 (&o)[DV / 16]) {
    bf16x8 pf[2];
#pragma unroll
    for (int ks = 0; ks < 2; ++ks) {
        u32x4 pw; pw[0] = cvt_pk_bf16(p[2 * ks][0], p[2 * ks][1]); pw[1] = cvt_pk_bf16(p[2 * ks][2], p[2 * ks][3]);
        pw[2] = cvt_pk_bf16(p[2 * ks + 1][0], p[2 * ks + 1][1]); pw[3] = cvt_pk_bf16(p[2 * ks + 1][2], p[2 * ks + 1][3]);
        pf[ks] = __builtin_bit_cast(bf16x8, pw);
    }
    const LAS unsigned char* base = Vt + fr * VSTR + fq * 8;
#pragma unroll
    for (int g = 0; g < DV / 64; ++g) {
        bf16x4 lo[4][2], hi[4][2];
#pragma unroll
        for (int d4 = 0; d4 < 4; ++d4)
#pragma unroll
            for (int ks = 0; ks < 2; ++ks) {
                const LAS unsigned char* q = base + (g * 4 + d4) * 16 * VSTR + ks * 64;
                lo[d4][ks] = *(const LAS bf16x4*)q; hi[d4][ks] = *(const LAS bf16x4*)(q + 32);
            }
#pragma unroll
        for (int ks = 0; ks < 2; ++ks)
#pragma unroll
            for (int d4 = 0; d4 < 4; ++d4) {
                const bf16x8 vf = __builtin_shufflevector(lo[d4][ks], hi[d4][ks], 0, 1, 2, 3, 4, 5, 6, 7);
                o[g * 4 + d4] = __builtin_amdgcn_mfma_f32_16x16x32_bf16(vf, pf[ks], o[g * 4 + d4], 0, 0, 0);
            }
    }
}
template <bool CHECK>
DI float softmax_step(f32x4 (&s)[4], float& m, float& l, int lane) {
    f32x4 mv = s[0];
#pragma unroll
    for (int nt = 1; nt < 4; ++nt)
#pragma unroll
        for (int j = 0; j < 4; ++j) mv[j] = fmaxf(mv[j], s[nt][j]);
    float mt = fmaxf(fmaxf(mv[0], mv[1]), fmaxf(mv[2], mv[3]));
    mt = fmaxf(mt, shx(mt, lane, 16)); mt = fmaxf(mt, shx(mt, lane, 32));
    const float mn = fmaxf(m, mt), alpha = __builtin_amdgcn_exp2f(m - mn);
    f32x4 ps = (f32x4){0.f, 0.f, 0.f, 0.f};
#pragma unroll
    for (int nt = 0; nt < 4; ++nt) {
        const f32x4 d = s[nt] - mn;
        f32x4 pv;
#pragma unroll
        for (int j = 0; j < 4; ++j) { pv[j] = __builtin_amdgcn_exp2f(d[j]); if (CHECK) pv[j] = (s[nt][j] > -1e29f) ? pv[j] : 0.f; }
        s[nt] = pv; ps += pv;
    }
    m = mn; l = l * alpha + ((ps[0] + ps[1]) + (ps[2] + ps[3]));
    return alpha;
}
DI int t5_bucket(int n) {
    if (n < 16) return n;
    int b = 16 + (int)(logf((float)n * (1.0f / 16.0f)) / 2.0794415416798357f * 16.0f);
    return b > 31 ? 31 : b;
}

DI void nsa_item(KP& P, LAS unsigned char* lds, int bl, int g, int tt, int wv) {
    const int tid = opq_v(TIDX), wid = tid >> 6, lane = tid & 63, fr = lane & 15, fq = lane >> 4;
    const int hh = wid & 3, ts = wid >> 2, t0 = tt * 32, t = t0 + ts * 16 + fr, bgi = bl * 2 + g, H = g * 4 + hh;
    const size_t row = (size_t)bl * 2048 + t;
    LAS float* bias = (LAS float*)(lds + A_BIAS);
    LAS float* part = (LAS float*)(lds + A_PART);
    LAS float* edge = (LAS float*)(lds + A_EDGE);
    LAS unsigned* selm = (LAS unsigned*)(lds + A_SELM);
    const bf16_t* ksb = (const bf16_t*)(P.ws + O_KS) + (size_t)bgi * 2048 * 128;
    const bf16_t* kwb = (const bf16_t*)(P.ws + O_KW) + (size_t)bgi * 2048 * 128;
    const bf16_t* vsb = (const bf16_t*)(P.ws + O_VST) + (size_t)bgi * 128 * 2048;
    const bf16_t* vwb = (const bf16_t*)(P.ws + O_VWT) + (size_t)bgi * 128 * 2048;
    u32x4 rk[2], rv[2];
    __syncthreads();
    {
        u32x4 ck[4], cv[4];
        g2r<256, 128>(ck, (const bf16_t*)(P.ws + O_KCMP) + (size_t)bgi * 128 * 128, 128, tid);
        g2r<256, 128>(cv, (const bf16_t*)(P.ws + O_VCMT) + (size_t)bgi * 128 * 128, 128, tid);
        for (int i = tid; i < 4 * 193; i += NT) { const int h4 = i / 193, r = i % 193 - 64; bias[h4 * 196 + r + 64] = r < 0 ? -1e30f : P.in[9][t5_bucket(r) * 8 + g * 4 + h4] * 1.4426950408889634f; }
        r2l<256, 128, 272>(ck, lds, tid);
        r2l<256, 128, 272>(cv, lds + N_STG, tid);
    }
    g2r<256, 64>(rk, ksb, 128, tid);
    g2r<128, 128>(rv, vsb, 2048, tid);
    bf16x8 qf[4];
    { const bf16_t* qp = (const bf16_t*)(P.ws + O_QA) + row * 1024 + H * 128 + fq * 8;
#pragma unroll
      for (int kk = 0; kk < 4; ++kk) qf[kk] = *(const bf16x8*)(qp + kk * 32); }
    const float* gt = (const float*)(P.ws + O_GATE) + row * 24;
    const float g0 = gt[H], g1 = gt[8 + H], g2 = gt[16 + H];
    f32x4 y[8];
#pragma unroll
    for (int i = 0; i < 8; ++i) y[i] = (f32x4){0.f, 0.f, 0.f, 0.f};
    __syncthreads();
    {
        f32x4 sc[2][4];
        qk_tile<128>(lds, fr, fq, qf, sc[0]);
        qk_tile<128>(lds + 64 * 272, fr, fq, qf, sc[1]);
        const LAS float* bh = bias + hh * 196 + 64;
        float mx = -1e30f;
#pragma unroll
        for (int kt = 0; kt < 2; ++kt)
#pragma unroll
            for (int nt = 0; nt < 4; ++nt)
#pragma unroll
                for (int j = 0; j < 4; ++j) {
                    const int n = kt * 64 + nt * 16 + fq * 4 + j, rel = t - 16 * n - 31;
                    const int ri = rel < 0 ? 0 : (rel > 128 ? 128 : rel);
                    const float v = rel >= 0 ? sc[kt][nt][j] * (0.08838834764831845f * 1.4426950408889634f) + bh[ri] : -1e30f;
                    sc[kt][nt][j] = v; mx = fmaxf(mx, v);
                }
        mx = fmaxf(mx, shx(mx, lane, 16)); mx = fmaxf(mx, shx(mx, lane, 32));
        float ls = 0.f;
#pragma unroll
        for (int kt = 0; kt < 2; ++kt)
#pragma unroll
            for (int nt = 0; nt < 4; ++nt)
#pragma unroll
                for (int j = 0; j < 4; ++j) { const float pv = sc[kt][nt][j] > -1e29f ? __builtin_amdgcn_exp2f(sc[kt][nt][j] - mx) : 0.f; sc[kt][nt][j] = pv; ls += pv; }
        ls += shx(ls, lane, 16); ls += shx(ls, lane, 32);
        const float inv = 1.0f / fmaxf(ls, 1e-30f);
#pragma unroll
        for (int kt = 0; kt < 2; ++kt)
#pragma unroll
            for (int nt = 0; nt < 4; ++nt) {
                sc[kt][nt] *= inv;
                const int jidx = kt * 16 + nt * 4 + fq, o = (hh * 32 + ts * 16 + fr) * 32 + jidx;
                part[o] = (sc[kt][nt][0] + sc[kt][nt][1]) + (sc[kt][nt][2] + sc[kt][nt][3]);
                edge[o] = sc[kt][nt][3];
            }
        f32x4 o[8];
#pragma unroll
        for (int i = 0; i < 8; ++i) o[i] = (f32x4){0.f, 0.f, 0.f, 0.f};
        pv_tile<128, 272>(lds + N_STG, fr, fq, sc[0], o);
        pv_tile<128, 272>(lds + N_STG + 128, fr, fq, sc[1], o);
#pragma unroll
        for (int i = 0; i < 8; ++i) y[i] += o[i] * g0;
    }
    __syncthreads();
#pragma unroll
    for (int pass = 0; pass < 2; ++pass) {
        const int tok = pass * 16 + wid * 2 + (lane >> 5), j = lane & 31;
        float v = 0.f;
#pragma unroll
        for (int h4 = 0; h4 < 4; ++h4) { const int o = (h4 * 32 + tok) * 32 + j; v += part[o] + (j > 0 ? edge[o - 1] : 0.f); }
        const int cur = (t0 + tok) >> 6;
        if (j == 0 || (cur - j >= 0 && cur - j < 2)) v = 1e4f;
        if (j > cur) v = -1.0f;
        int rank = 0;
#pragma unroll
        for (int i = 0; i < 32; ++i) { const float vi = shl(v, (lane & 32) + i); rank += (vi > v || (vi == v && i < j)) ? 1 : 0; }
        const unsigned long long bal = __ballot(rank < 16);
        if (j == 0) selm[tok] = (unsigned)((lane & 32) ? (bal >> 32) : (bal & 0xffffffffull));
    }
    __syncthreads();
    unsigned um = selm[lane & 31];
#pragma unroll
    for (int o = 16; o > 0; o >>= 1) um |= (unsigned)__builtin_amdgcn_ds_bpermute((lane ^ o) << 2, (int)um);
    um = (unsigned)__builtin_amdgcn_readfirstlane((int)um);
    const unsigned mysel = selm[ts * 16 + fr];
    const int kt_hi = t0 >> 6, kt_lo_w = (t0 - 511) > 0 ? ((t0 - 511) >> 6) : 0;
    um &= (kt_hi >= 31) ? 0xffffffffu : ((2u << kt_hi) - 1u);
    const LAS float* bh = bias + hh * 196 + 64;
    f32x4 o[8];
#pragma unroll
    for (int i = 0; i < 8; ++i) o[i] = (f32x4){0.f, 0.f, 0.f, 0.f};
    float m = -1e30f, l = 0.f;
    auto advance = [&](int md, int k, int& md2, int& k2) -> bool {
        md2 = md; k2 = k + 1;
        if (md == 1) {
            const unsigned rem = (k >= 31) ? 0u : (um & ~((2u << k) - 1u));
            if (rem) k2 = __builtin_ctz(rem); else { md2 = 2; k2 = kt_lo_w; }
            return false;
        }
        return k2 > kt_hi;
    };
    int mode = 1, kt = 0, mode2, kt2, cur = 0;
    r2l<256, 64, 272>(rk, lds + N_K, tid);
    r2l<128, 128, 144>(rv, lds + N_V, tid);
    bool done2 = advance(mode, kt, mode2, kt2);
    if (!done2) {
        g2r<256, 64>(rk, (mode2 == 1 ? ksb : kwb) + (size_t)kt2 * 64 * 128, 128, tid);
        g2r<128, 128>(rv, (mode2 == 1 ? vsb : vwb) + kt2 * 64, 2048, tid);
    }
    __syncthreads();
    for (;;) {
        LAS unsigned char* sb = lds + cur * N_STG;
        int mode3 = 0, kt3 = 0; bool done3 = true;
        if (!done2) {
            r2l<256, 64, 272>(rk, lds + (cur ^ 1) * N_STG + N_K, tid);
            r2l<128, 128, 144>(rv, lds + (cur ^ 1) * N_STG + N_V, tid);
            done3 = advance(mode2, kt2, mode3, kt3);
            if (!done3) {
                g2r<256, 64>(rk, (mode3 == 1 ? ksb : kwb) + (size_t)kt3 * 64 * 128, 128, tid);
                g2r<128, 128>(rv, (mode3 == 1 ? vsb : vwb) + kt3 * 64, 2048, tid);
            }
        }
        f32x4 s[4];
        qk_tile<128>(sb + N_K, fr, fq, qf, s);
        const bool selok = mode == 2 || ((mysel >> kt) & 1u) != 0u;
        const bool near = kt * 64 + 191 > t0;
        const bool far = !near && (mode == 1 || (t0 + 31 - kt * 64 < 512));
        float alpha;
        if (far) {
            const float b128 = bh[128];
#pragma unroll
            for (int nt = 0; nt < 4; ++nt)
#pragma unroll
                for (int j = 0; j < 4; ++j) s[nt][j] = selok ? fmaf(s[nt][j], 0.08838834764831845f * LOG2E_, b128) : -1e30f;
            alpha = softmax_step<false>(s, m, l, lane);
        } else if (near) {
            const int r0 = t - kt * 64 - fq * 4;
#pragma unroll
            for (int nt = 0; nt < 4; ++nt)
#pragma unroll
                for (int j = 0; j < 4; ++j) {
                    int rel = r0 - (nt * 16 + j); rel = rel > 128 ? 128 : rel;
                    const float v = fmaf(s[nt][j], 0.08838834764831845f * LOG2E_, bh[rel]);
                    s[nt][j] = selok ? v : -1e30f;
                }
            alpha = softmax_step<false>(s, m, l, lane);
        } else {
            const float b128 = bh[128];
            const int r0 = t - kt * 64 - fq * 4;
#pragma unroll
            for (int nt = 0; nt < 4; ++nt)
#pragma unroll
                for (int j = 0; j < 4; ++j) s[nt][j] = (r0 - (nt * 16 + j) < 512) ? fmaf(s[nt][j], 0.08838834764831845f * LOG2E_, b128) : -1e30f;
            alpha = softmax_step<true>(s, m, l, lane);
        }
#pragma unroll
        for (int i = 0; i < 8; ++i) o[i] *= alpha;
        pv_tile<128, 144>(sb + N_V, fr, fq, s, o);
        if (done2 || mode2 != mode) {
            l += shx(l, lane, 16); l += shx(l, lane, 32);
            const float sc = (mode == 1 ? g1 : g2) / fmaxf(l, 1e-30f);
#pragma unroll
            for (int i = 0; i < 8; ++i) { y[i] += o[i] * sc; o[i] = (f32x4){0.f, 0.f, 0.f, 0.f}; }
            m = -1e30f; l = 0.f;
        }
        if (done2) break;
        __syncthreads();
        cur ^= 1; mode = mode2; kt = kt2; mode2 = mode3; kt2 = kt3; done2 = done3;
    }
    bf16_t* yo = (bf16_t*)(P.ws + O_YA) + row * 1024 + H * 128 + fq * 4;
#pragma unroll
    for (int i = 0; i < 8; ++i) st4(yo + i * 16, y[i]);
}

DI void qk_tile2(const LAS unsigned char* Ks, int fr, int fq, const bf16x8 (&q0)[4], const bf16x8 (&q1)[4], f32x4 (&s0)[4], f32x4 (&s1)[4]) {
    const LAS unsigned char* base = Ks + fr * 272 + fq * 16;
#pragma unroll
    for (int nt = 0; nt < 4; ++nt) {
        bf16x8 kf[4];
#pragma unroll
        for (int kk = 0; kk < 4; ++kk) kf[kk] = *(const LAS bf16x8*)(base + nt * 16 * 272 + kk * 64);
        f32x4 a = (f32x4){0.f, 0.f, 0.f, 0.f}, b = (f32x4){0.f, 0.f, 0.f, 0.f};
#pragma unroll
        for (int kk = 0; kk < 4; ++kk) { a = __builtin_amdgcn_mfma_f32_16x16x32_bf16(kf[kk], q0[kk], a, 0, 0, 0); b = __builtin_amdgcn_mfma_f32_16x16x32_bf16(kf[kk], q1[kk], b, 0, 0, 0); }
        s0[nt] = a; s1[nt] = b;
    }
}
template <int VSTR>
DI void pv_tile2(const LAS unsigned char* Vt, int fr, int fq, const f32x4 (&p0)[4], const f32x4 (&p1)[4], f32x4 (&o0)[8], f32x4 (&o1)[8]) {
    bf16x8 pf0[2], pf1[2];
#pragma unroll
    for (int ks = 0; ks < 2; ++ks) {
        u32x4 a, b;
        a[0] = cvt_pk_bf16(p0[2 * ks][0], p0[2 * ks][1]); a[1] = cvt_pk_bf16(p0[2 * ks][2], p0[2 * ks][3]); a[2] = cvt_pk_bf16(p0[2 * ks + 1][0], p0[2 * ks + 1][1]); a[3] = cvt_pk_bf16(p0[2 * ks + 1][2], p0[2 * ks + 1][3]);
        b[0] = cvt_pk_bf16(p1[2 * ks][0], p1[2 * ks][1]); b[1] = cvt_pk_bf16(p1[2 * ks][2], p1[2 * ks][3]); b[2] = cvt_pk_bf16(p1[2 * ks + 1][0], p1[2 * ks + 1][1]); b[3] = cvt_pk_bf16(p1[2 * ks + 1][2], p1[2 * ks + 1][3]);
        pf0[ks] = __builtin_bit_cast(bf16x8, a); pf1[ks] = __builtin_bit_cast(bf16x8, b);
    }
    const LAS unsigned char* base = Vt + fr * VSTR + fq * 8;
#pragma unroll
    for (int g = 0; g < 4; ++g) {
        bf16x4 lo[2][2], hi[2][2];
#pragma unroll
        for (int d2 = 0; d2 < 2; ++d2)
#pragma unroll
            for (int ks = 0; ks < 2; ++ks) { const LAS unsigned char* q = base + (g * 2 + d2) * 16 * VSTR + ks * 64; lo[d2][ks] = *(const LAS bf16x4*)q; hi[d2][ks] = *(const LAS bf16x4*)(q + 32); }
#pragma unroll
        for (int ks = 0; ks < 2; ++ks)
#pragma unroll
            for (int d2 = 0; d2 < 2; ++d2) {
                const bf16x8 vf = __builtin_shufflevector(lo[d2][ks], hi[d2][ks], 0, 1, 2, 3, 4, 5, 6, 7);
                o0[g * 2 + d2] = __builtin_amdgcn_mfma_f32_16x16x32_bf16(vf, pf0[ks], o0[g * 2 + d2], 0, 0, 0);
                o1[g * 2 + d2] = __builtin_amdgcn_mfma_f32_16x16x32_bf16(vf, pf1[ks], o1[g * 2 + d2], 0, 0, 0);
            }
    }
}
DI f32x4 unpk4(u32x2 w) { f32x4 r; r[0] = __uint_as_float(w.x << 16); r[1] = __uint_as_float(w.x & 0xffff0000u); r[2] = __uint_as_float(w.y << 16); r[3] = __uint_as_float(w.y & 0xffff0000u); return r; }
DI u32x2 pk4(f32x4 v) { u32x2 w; w.x = cvt_pk_bf16(v[0], v[1]); w.y = cvt_pk_bf16(v[2], v[3]); return w; }
DI void nsa_item2(KP& P, LAS unsigned char* lds, int bl, int g, int tt, int wv) {
    const int tid = opq_v(TIDX), wid = tid >> 6, lane = tid & 63, fr = lane & 15, fq = lane >> 4;
    const int hp = wid & 1, ts = wid >> 1, t0 = tt * 64, t = t0 + ts * 16 + fr, bgi = bl * 2 + g, H0 = g * 4 + hp * 2;
    const size_t row = (size_t)bl * 2048 + t;
    constexpr int KST = 17408, VB = 34816, VST = 18432, A2_BIAS = VB + 3 * VST, A2_PART = A2_BIAS + 3136, A2_EDGE = A2_PART + 16384, A2_SELM = A2_EDGE + 16384;
    static_assert(A2_SELM + 256 <= LDS_PHASE, "nsa2 LDS");
    LAS float* bias = (LAS float*)(lds + A2_BIAS);
    LAS float* part = (LAS float*)(lds + A2_PART);
    LAS float* edge = (LAS float*)(lds + A2_EDGE);
    LAS unsigned* selm = (LAS unsigned*)(lds + A2_SELM);
    const bf16_t* ksb = (const bf16_t*)(P.ws + O_KS) + (size_t)bgi * 2048 * 128;
    const bf16_t* kwb = (const bf16_t*)(P.ws + O_KW) + (size_t)bgi * 2048 * 128;
    const bf16_t* vsb = (const bf16_t*)(P.ws + O_VST) + (size_t)bgi * 128 * 2048;
    const bf16_t* vwb = (const bf16_t*)(P.ws + O_VWT) + (size_t)bgi * 128 * 2048;
    u32x4 rk[2], rv[2];
    __syncthreads();
    {
        u32x4 ck[4], cv[4];
        g2r<256, 128>(ck, (const bf16_t*)(P.ws + O_KCMP) + (size_t)bgi * 128 * 128, 128, tid);
        g2r<256, 128>(cv, (const bf16_t*)(P.ws + O_VCMT) + (size_t)bgi * 128 * 128, 128, tid);
        for (int i = tid; i < 4 * 193; i += NT) { const int h4 = i / 193, r = i % 193 - 64; bias[h4 * 196 + r + 64] = r < 0 ? -1e30f : P.in[9][t5_bucket(r) * 8 + g * 4 + h4] * 1.4426950408889634f; }
        r2l<256, 128, 272>(ck, lds, tid);
        r2l<256, 128, 272>(cv, lds + VB, tid);
    }
    bf16x8 q0[4], q1[4];
    { const bf16_t* qp = (const bf16_t*)(P.ws + O_QA) + row * 1024 + H0 * 128 + fq * 8;
#pragma unroll
      for (int kk = 0; kk < 4; ++kk) { q0[kk] = *(const bf16x8*)(qp + kk * 32); q1[kk] = *(const bf16x8*)(qp + 128 + kk * 32); } }
    const float* gt = (const float*)(P.ws + O_GATE) + row * 24 + H0;
    const float g00 = gt[0], g01 = gt[1], g10 = gt[8], g11 = gt[9], g20 = gt[16], g21 = gt[17];
    const LAS float* bh0 = bias + (hp * 2) * 196 + 64;
    const LAS float* bh1 = bh0 + 196;
    bf16_t* yo = (bf16_t*)(P.ws + O_YA) + row * 1024 + H0 * 128 + fq * 4;
    __syncthreads();
#pragma unroll
    for (int hd = 0; hd < 2; ++hd) {
        f32x4 sc[2][4];
        qk_tile<128>(lds, fr, fq, hd ? q1 : q0, sc[0]);
        qk_tile<128>(lds + 64 * 272, fr, fq, hd ? q1 : q0, sc[1]);
        const LAS float* bh = hd ? bh1 : bh0;
        float mx = -1e30f;
#pragma unroll
        for (int kt = 0; kt < 2; ++kt)
#pragma unroll
            for (int nt = 0; nt < 4; ++nt)
#pragma unroll
                for (int j = 0; j < 4; ++j) {
                    const int n = kt * 64 + nt * 16 + fq * 4 + j; int rel = t - 16 * n - 31;
                    rel = rel < -64 ? -64 : (rel > 128 ? 128 : rel);
                    const float v = fmaf(sc[kt][nt][j], 0.08838834764831845f * LOG2E_, bh[rel]);
                    sc[kt][nt][j] = v; mx = fmaxf(mx, v);
                }
        mx = fmaxf(mx, shx(mx, lane, 16)); mx = fmaxf(mx, shx(mx, lane, 32));
        float ls = 0.f;
#pragma unroll
        for (int kt = 0; kt < 2; ++kt)
#pragma unroll
            for (int nt = 0; nt < 4; ++nt)
#pragma unroll
                for (int j = 0; j < 4; ++j) { const float pv = sc[kt][nt][j] > -1e29f ? __builtin_amdgcn_exp2f(sc[kt][nt][j] - mx) : 0.f; sc[kt][nt][j] = pv; ls += pv; }
        ls += shx(ls, lane, 16); ls += shx(ls, lane, 32);
        const float inv = 1.0f / fmaxf(ls, 1e-30f);
#pragma unroll
        for (int kt = 0; kt < 2; ++kt)
#pragma unroll
            for (int nt = 0; nt < 4; ++nt) {
                sc[kt][nt] *= inv;
                const int jidx = kt * 16 + nt * 4 + fq, oo = (hp * 64 + ts * 16 + fr) * 32 + jidx;
                const float ps = (sc[kt][nt][0] + sc[kt][nt][1]) + (sc[kt][nt][2] + sc[kt][nt][3]);
                if (hd == 0) { part[oo] = ps; edge[oo] = sc[kt][nt][3]; } else { part[oo] += ps; edge[oo] += sc[kt][nt][3]; }
            }
        f32x4 oc[8];
#pragma unroll
        for (int i = 0; i < 8; ++i) oc[i] = (f32x4){0.f, 0.f, 0.f, 0.f};
        pv_tile<128, 272>(lds + VB, fr, fq, sc[0], oc);
        pv_tile<128, 272>(lds + VB + 128, fr, fq, sc[1], oc);
        const float gc = hd ? g01 : g00;
#pragma unroll
        for (int i = 0; i < 8; ++i) st4(yo + hd * 128 + i * 16, oc[i] * gc);
    }
    g2r<256, 64>(rk, ksb, 128, tid);
    g2r<128, 128>(rv, vsb, 2048, tid);
    __syncthreads();
#pragma unroll
    for (int pass = 0; pass < 4; ++pass) {
        const int tok = pass * 16 + wid * 2 + (lane >> 5), j = lane & 31;
        float v = 0.f;
#pragma unroll
        for (int h2 = 0; h2 < 2; ++h2) { const int oo = (h2 * 64 + tok) * 32 + j; v += part[oo] + (j > 0 ? edge[oo - 1] : 0.f); }
        const int cur = tt;
        if (j == 0 || (cur - j >= 0 && cur - j < 2)) v = 1e4f;
        if (j > cur) v = -1.0f;
        int rank = 0;
#pragma unroll
        for (int i = 0; i < 32; ++i) { const float vi = shl(v, (lane & 32) + i); rank += (vi > v || (vi == v && i < j)) ? 1 : 0; }
        const unsigned long long bal = __ballot(rank < 16);
        if (j == 0) selm[tok] = (unsigned)((lane & 32) ? (bal >> 32) : (bal & 0xffffffffull));
    }
    __syncthreads();
    unsigned um = selm[lane];
#pragma unroll
    for (int oo = 32; oo > 0; oo >>= 1) um |= (unsigned)__builtin_amdgcn_ds_bpermute((lane ^ oo) << 2, (int)um);
    um = (unsigned)__builtin_amdgcn_readfirstlane((int)um);
    const unsigned mysel = selm[ts * 16 + fr];
    const int kt_hi = tt, kt_lo_w = (t0 - 511) > 0 ? ((t0 - 511) >> 6) : 0;
    um &= (kt_hi >= 31) ? 0xffffffffu : ((2u << kt_hi) - 1u);
    f32x4 o0[8], o1[8];
#pragma unroll
    for (int i = 0; i < 8; ++i) { o0[i] = (f32x4){0.f, 0.f, 0.f, 0.f}; o1[i] = (f32x4){0.f, 0.f, 0.f, 0.f}; }
    float m0 = -1e30f, l0 = 0.f, m1 = -1e30f, l1 = 0.f;
    auto advance = [&](int md, int k, int& md2, int& k2) -> bool {
        md2 = md; k2 = k + 1;
        if (md == 1) {
            const unsigned rem = (k >= 31) ? 0u : (um & ~((2u << k) - 1u));
            if (rem) k2 = __builtin_ctz(rem); else { md2 = 2; k2 = kt_lo_w; }
            return false;
        }
        return k2 > kt_hi;
    };
    const bool grpB = wid >= 4;
    int mode = 1, kt = 0, mode2, kt2, step = 0, pmode = 1; bool plast = false;
    f32x4 s0[4], s1[4];
    r2l<256, 64, 272>(rk, lds, tid);
    r2l<128, 128, 144>(rv, lds + VB, tid);
    bool done2 = advance(mode, kt, mode2, kt2);
    if (!done2) { g2r<256, 64>(rk, (mode2 == 1 ? ksb : kwb) + (size_t)kt2 * 64 * 128, 128, tid); g2r<128, 128>(rv, (mode2 == 1 ? vsb : vwb) + kt2 * 64, 2048, tid); }
    __syncthreads();
    auto finalize = [&](int md) {
        l0 += shx(l0, lane, 16); l0 += shx(l0, lane, 32); l1 += shx(l1, lane, 16); l1 += shx(l1, lane, 32);
        const float c0 = (md == 1 ? g10 : g20) / fmaxf(l0, 1e-30f), c1 = (md == 1 ? g11 : g21) / fmaxf(l1, 1e-30f);
        asm volatile("s_waitcnt vmcnt(0)" ::: "memory");
#pragma unroll
        for (int i = 0; i < 8; ++i) {
            const u32x2 w0 = *(const u32x2*)(yo + i * 16), w1 = *(const u32x2*)(yo + 128 + i * 16);
            st4(yo + i * 16, unpk4(w0) + o0[i] * c0); st4(yo + 128 + i * 16, unpk4(w1) + o1[i] * c1);
            o0[i] = (f32x4){0.f, 0.f, 0.f, 0.f}; o1[i] = (f32x4){0.f, 0.f, 0.f, 0.f};
        }
        m0 = -1e30f; l0 = 0.f; m1 = -1e30f; l1 = 0.f;
    };
    for (;;) {
        const int ks = step & 1, vs = step % 3;
        int mode3 = 0, kt3 = 0; bool done3 = true;
        if (!done2) {
            r2l<256, 64, 272>(rk, lds + (ks ^ 1) * KST, tid);
            r2l<128, 128, 144>(rv, lds + VB + ((step + 1) % 3) * VST, tid);
            done3 = advance(mode2, kt2, mode3, kt3);
            if (!done3) { g2r<256, 64>(rk, (mode3 == 1 ? ksb : kwb) + (size_t)kt3 * 64 * 128, 128, tid); g2r<128, 128>(rv, (mode3 == 1 ? vsb : vwb) + kt3 * 64, 2048, tid); }
        }
        if (grpB && step > 0) {
            pv_tile2<144>(lds + VB + ((step + 2) % 3) * VST, fr, fq, s0, s1, o0, o1);
            if (plast) finalize(pmode);
        }
        qk_tile2(lds + ks * KST, fr, fq, q0, q1, s0, s1);
        const bool selok = mode == 2 || ((mysel >> kt) & 1u) != 0u;
        const bool near = kt * 64 + 191 > t0;
        const bool far = !near && (mode == 1 || (t0 + 63 - kt * 64 < 512));
        float al0, al1;
        if (far) {
            const float b0 = selok ? bh0[128] : -1e30f, b1 = selok ? bh1[128] : -1e30f;
#pragma unroll
            for (int nt = 0; nt < 4; ++nt) { s0[nt] = s0[nt] * (0.08838834764831845f * LOG2E_) + b0; s1[nt] = s1[nt] * (0.08838834764831845f * LOG2E_) + b1; }
            al0 = softmax_step<false>(s0, m0, l0, lane); al1 = softmax_step<false>(s1, m1, l1, lane);
        } else if (near) {
            const int r0 = t - kt * 64 - fq * 4;
#pragma unroll
            for (int nt = 0; nt < 4; ++nt)
#pragma unroll
                for (int j = 0; j < 4; ++j) {
                    int rel = r0 - (nt * 16 + j); rel = rel > 128 ? 128 : rel;
                    const float v0 = fmaf(s0[nt][j], 0.08838834764831845f * LOG2E_, bh0[rel]), v1 = fmaf(s1[nt][j], 0.08838834764831845f * LOG2E_, bh1[rel]);
                    s0[nt][j] = selok ? v0 : -1e30f; s1[nt][j] = selok ? v1 : -1e30f;
                }
            al0 = softmax_step<false>(s0, m0, l0, lane); al1 = softmax_step<false>(s1, m1, l1, lane);
        } else {
            const float b0 = bh0[128], b1 = bh1[128];
            const int r0 = t - kt * 64 - fq * 4;
#pragma unroll
            for (int nt = 0; nt < 4; ++nt)
#pragma unroll
                for (int j = 0; j < 4; ++j) {
                    const bool in = r0 - (nt * 16 + j) < 512;
                    s0[nt][j] = in ? fmaf(s0[nt][j], 0.08838834764831845f * LOG2E_, b0) : -1e30f; s1[nt][j] = in ? fmaf(s1[nt][j], 0.08838834764831845f * LOG2E_, b1) : -1e30f;
                }
            al0 = softmax_step<true>(s0, m0, l0, lane); al1 = softmax_step<true>(s1, m1, l1, lane);
        }
        if (__builtin_amdgcn_ballot_w64(al0 != 1.0f || al1 != 1.0f) != 0ull) {
#pragma unroll
            for (int i = 0; i < 8; ++i) { o0[i] *= al0; o1[i] *= al1; }
        }
        const bool last = done2 || mode2 != mode;
        if (!grpB) {
            pv_tile2<144>(lds + VB + vs * VST, fr, fq, s0, s1, o0, o1);
            if (last) finalize(mode);
        }
        pmode = mode; plast = last;
        if (done2) break;
        __syncthreads();
        ++step; mode = mode2; kt = kt2; mode2 = mode3; kt2 = kt3; done2 = done3;
    }
    if (grpB) { pv_tile2<144>(lds + VB + (step % 3) * VST, fr, fq, s0, s1, o0, o1); finalize(pmode); }
}

DI void ret_item(KP& P, LAS unsigned char* lds, int bl, int h, int qt, int wv) {
    const int tid = opq_v(TIDX), wid = tid >> 6, lane = tid & 63, fr = lane & 15, fq = lane >> 4;
    const int t0 = qt * 128, t = t0 + wid * 16 + fr;
    const size_t row = (size_t)bl * 2048 + t;
    const bf16_t* kb = (const bf16_t*)(P.ws + O_RK) + (size_t)bl * 2048 * 512 + h * 128;
    const bf16_t* vb = (const bf16_t*)(P.ws + O_RVT) + ((size_t)bl * 1024 + h * 256) * 2048;
    u32x4 rk[2], rv[4];
    g2r<256, 64>(rk, kb, 512, tid);
    g2r<128, 256>(rv, vb, 2048, tid);
    bf16x8 qf[4];
    { const bf16_t* qp = (const bf16_t*)(P.ws + O_RQ) + row * 512 + h * 128 + fq * 8;
#pragma unroll
      for (int kk = 0; kk < 4; ++kk) qf[kk] = *(const bf16x8*)(qp + kk * 32); }
    const float lg = log2f(1.0f - exp2f(-5.0f - (float)h));
    f32x4 bdec[4];
#pragma unroll
    for (int nt = 0; nt < 4; ++nt)
#pragma unroll
        for (int j = 0; j < 4; ++j) bdec[nt][j] = exp2f(-(float)(nt * 16 + fq * 4 + j) * lg);
    f32x4 o[16];
#pragma unroll
    for (int i = 0; i < 16; ++i) o[i] = (f32x4){0.f, 0.f, 0.f, 0.f};
    const int kt_hi = (t0 + 127) >> 6;
    __syncthreads();
    r2l<256, 64, 272>(rk, lds + R_K, tid);
    r2l<128, 256, 144>(rv, lds + R_V, tid);
    if (kt_hi >= 1) { g2r<256, 64>(rk, kb + (size_t)64 * 512, 512, tid); g2r<128, 256>(rv, vb + 64, 2048, tid); }
    __syncthreads();
    for (int kt = 0; kt <= kt_hi; ++kt) {
        LAS unsigned char* sb = lds + (kt & 1) * R_STG;
        if (kt < kt_hi) {
            r2l<256, 64, 272>(rk, lds + ((kt + 1) & 1) * R_STG + R_K, tid);
            r2l<128, 256, 144>(rv, lds + ((kt + 1) & 1) * R_STG + R_V, tid);
            if (kt + 1 < kt_hi) { g2r<256, 64>(rk, kb + (size_t)(kt + 2) * 64 * 512, 512, tid); g2r<128, 256>(rv, vb + (kt + 2) * 64, 2048, tid); }
        }
        f32x4 s[4];
        qk_tile<128>(sb + R_K, fr, fq, qf, s);
        const float at = __builtin_amdgcn_exp2f((float)(t - kt * 64) * lg);
        if (kt * 64 + 63 <= t0) {
#pragma unroll
            for (int nt = 0; nt < 4; ++nt) s[nt] *= bdec[nt] * at;
        } else {
#pragma unroll
            for (int nt = 0; nt < 4; ++nt)
#pragma unroll
                for (int j = 0; j < 4; ++j) {
                    const int rel = t - (kt * 64 + nt * 16 + fq * 4 + j);
                    s[nt][j] = rel >= 0 ? s[nt][j] * (bdec[nt][j] * at) : 0.f;
                }
        }
        pv_tile<256, 144>(sb + R_V, fr, fq, s, o);
        __syncthreads();
    }
    float sm = 0.f;
#pragma unroll
    for (int i = 0; i < 16; ++i) sm += (o[i][0] + o[i][1]) + (o[i][2] + o[i][3]);
    sm += shx(sm, lane, 16); sm += shx(sm, lane, 32);
    const float mu = sm * (1.0f / 256.0f);
    float vs = 0.f;
#pragma unroll
    for (int i = 0; i < 16; ++i)
#pragma unroll
        for (int j = 0; j < 4; ++j) { const float d = o[i][j] - mu; vs += d * d; }
    vs += shx(vs, lane, 16); vs += shx(vs, lane, 32);
    const float rs = rsqrtf(vs * (1.0f / 256.0f) + EPS);
    const bf16_t* rg = (const bf16_t*)(P.ws + O_RG) + row * 1024 + h * 256 + fq * 4;
    bf16_t* yo = (bf16_t*)(P.ws + O_YB) + row * 1024 + h * 256 + fq * 4;
#pragma unroll
    for (int i = 0; i < 16; ++i) {
        const bf16x4 gv = *(const bf16x4*)(rg + i * 16);
        f32x4 v;
#pragma unroll
        for (int j = 0; j < 4; ++j) v[j] = (o[i][j] - mu) * rs * bf2f((unsigned short)gv[j]);
        st4(yo + i * 16, v);
    }
}

DI void mem_item(KP& P, LAS unsigned char* lds, int bl, int hm, int qt, int wv) {
    const int tid = opq_v(TIDX), wid = tid >> 6, lane = tid & 63, fr = lane & 15, fq = lane >> 4;
    const size_t row = (size_t)bl * 2048 + qt * 128 + wid * 16 + fr;
    const bf16_t* kb = (const bf16_t*)(P.ws + O_MK) + (size_t)bl * 256 * 1024 + hm * 256;
    const bf16_t* vb = (const bf16_t*)(P.ws + O_MVT) + ((size_t)bl * 1024 + hm * 256) * 256;
    u32x4 rk[4], rv[4];
    g2r<512, 64>(rk, kb, 1024, tid);
    g2r<128, 256>(rv, vb, 256, tid);
    bf16x8 qf[8];
    { const bf16_t* qp = (const bf16_t*)(P.ws + O_MQ) + row * 1024 + hm * 256 + fq * 8;
#pragma unroll
      for (int kk = 0; kk < 8; ++kk) qf[kk] = *(const bf16x8*)(qp + kk * 32); }
    f32x4 o[16];
#pragma unroll
    for (int i = 0; i < 16; ++i) o[i] = (f32x4){0.f, 0.f, 0.f, 0.f};
    float m = -1e30f, l = 0.f;
    constexpr int M_V = 33792, M_STG = M_V + 36864;
    static_assert(2 * M_STG <= LDS_PHASE, "memory attention LDS");
    __syncthreads();
    r2l<512, 64, 528>(rk, lds, tid);
    r2l<128, 256, 144>(rv, lds + M_V, tid);
    g2r<512, 64>(rk, kb + (size_t)64 * 1024, 1024, tid); g2r<128, 256>(rv, vb + 64, 256, tid);
    __syncthreads();
    for (int kt = 0; kt < 4; ++kt) {
        LAS unsigned char* sb = lds + (kt & 1) * M_STG;
        if (kt < 3) {
            r2l<512, 64, 528>(rk, lds + ((kt + 1) & 1) * M_STG, tid);
            r2l<128, 256, 144>(rv, lds + ((kt + 1) & 1) * M_STG + M_V, tid);
            if (kt < 2) { g2r<512, 64>(rk, kb + (size_t)(kt + 2) * 64 * 1024, 1024, tid); g2r<128, 256>(rv, vb + (kt + 2) * 64, 256, tid); }
        }
        f32x4 s[4];
        qk_tile<256>(sb, fr, fq, qf, s);
#pragma unroll
        for (int nt = 0; nt < 4; ++nt) s[nt] *= 0.0625f * LOG2E_;
        const float alpha = softmax_step<false>(s, m, l, lane);
#pragma unroll
        for (int i = 0; i < 16; ++i) o[i] *= alpha;
        pv_tile<256, 144>(sb + M_V, fr, fq, s, o);
        __syncthreads();
    }
    l += shx(l, lane, 16); l += shx(l, lane, 32);
    const float inv = 1.0f / l;
    bf16_t* yo = (bf16_t*)(P.ws + O_YC) + row * 1024 + hm * 256 + fq * 4;
#pragma unroll
    for (int i = 0; i < 16; ++i) st4(yo + i * 16, o[i] * inv);
}

DI void rms_rows(const float* x, const float* g, bf16_t* out, int nrows, int wv) {
    const int tidq = opq_v(TIDX), lane = tidq & 63, gw = opq_s(blockIdx.x) * 8 + (tidq >> 6), nw = gridDim.x * 8;
    for (int r = gw; r < nrows; r += nw) {
        const float* xr = x + (size_t)r * 2048;
        f32x4 v[8]; float ss = 0.f;
#pragma unroll
        for (int i = 0; i < 4; ++i) {
            v[2 * i] = *(const f32x4*)(xr + i * 512 + lane * 8); v[2 * i + 1] = *(const f32x4*)(xr + i * 512 + lane * 8 + 4);
#pragma unroll
            for (int j = 0; j < 4; ++j) ss += v[2 * i][j] * v[2 * i][j] + v[2 * i + 1][j] * v[2 * i + 1][j];
        }
        ss = wave_sum(ss, lane);
        const float rs = rsqrtf(ss * (1.0f / 2048.0f) + EPS);
#pragma unroll
        for (int i = 0; i < 4; ++i) {
            const f32x4 ga = *(const f32x4*)(g + i * 512 + lane * 8), gb = *(const f32x4*)(g + i * 512 + lane * 8 + 4);
            st4(out + (size_t)r * 2048 + i * 512 + lane * 8, v[2 * i] * rs * ga);
            st4(out + (size_t)r * 2048 + i * 512 + lane * 8 + 4, v[2 * i + 1] * rs * gb);
        }
    }
}
template <int MODE>
DI void resid_rows(const float* xf, const bf16_t* xb, const bf16_t* y, const float* g1, const float* g2, float* outf, bf16_t* outb, bf16_t* h2, int nrows, int wv) {
    const int tidq = opq_v(TIDX), lane = tidq & 63, gw = opq_s(blockIdx.x) * 8 + (tidq >> 6), nw = gridDim.x * 8;
    for (int r = gw; r < nrows; r += 2 * nw) {
        const bool two = r + nw < nrows;
        const int rows[2] = {r, two ? r + nw : r};
        bf16x8 yb[2][4]; f32x4 xv[2][8];
#pragma unroll
        for (int rr = 0; rr < 2; ++rr) {
#pragma unroll
            for (int i = 0; i < 4; ++i) yb[rr][i] = *(const bf16x8*)(y + (size_t)rows[rr] * 2048 + i * 512 + lane * 8);
#pragma unroll
            for (int i = 0; i < 4; ++i) {
                if (MODE == 1) { xv[rr][2 * i] = *(const f32x4*)(xf + (size_t)rows[rr] * 2048 + i * 512 + lane * 8); xv[rr][2 * i + 1] = *(const f32x4*)(xf + (size_t)rows[rr] * 2048 + i * 512 + lane * 8 + 4); }
                else { const bf16x8 b = *(const bf16x8*)(xb + (size_t)rows[rr] * 2048 + i * 512 + lane * 8);
#pragma unroll
                    for (int j = 0; j < 4; ++j) { xv[rr][2 * i][j] = bf2f((unsigned short)b[j]); xv[rr][2 * i + 1][j] = bf2f((unsigned short)b[4 + j]); } }
            }
        }
#pragma unroll
        for (int rr = 0; rr < 2; ++rr) {
            if (rr == 1 && !two) break;
            float yv[32]; float ss = 0.f;
#pragma unroll
            for (int i = 0; i < 4; ++i)
#pragma unroll
                for (int j = 0; j < 8; ++j) { const float f = bf2f((unsigned short)yb[rr][i][j]); yv[i * 8 + j] = f; ss += f * f; }
            ss = wave_sum(ss, lane);
            const float rs = rsqrtf(ss * (1.0f / 2048.0f) + EPS);
            float s2 = 0.f;
#pragma unroll
            for (int i = 0; i < 4; ++i) {
                const int c = i * 512 + lane * 8;
                const f32x4 ga = *(const f32x4*)(g1 + c), gb = *(const f32x4*)(g1 + c + 4);
                f32x4 oa, ob;
#pragma unroll
                for (int j = 0; j < 4; ++j) {
                    oa[j] = xv[rr][2 * i][j] + yv[i * 8 + j] * rs * ga[j]; ob[j] = xv[rr][2 * i + 1][j] + yv[i * 8 + 4 + j] * rs * gb[j];
                    yv[i * 8 + j] = oa[j]; yv[i * 8 + 4 + j] = ob[j]; s2 += oa[j] * oa[j] + ob[j] * ob[j];
                }
                if (MODE == 1) *(u32x4*)(outb + (size_t)rows[rr] * 2048 + c) = pk8(oa, ob);
                else { *(f32x4*)(outf + (size_t)rows[rr] * 2048 + c) = oa; *(f32x4*)(outf + (size_t)rows[rr] * 2048 + c + 4) = ob; }
            }
            if (MODE == 1) {
                s2 = wave_sum(s2, lane);
                const float r2 = rsqrtf(s2 * (1.0f / 2048.0f) + EPS);
#pragma unroll
                for (int i = 0; i < 4; ++i) {
                    const int c = i * 512 + lane * 8;
                    const f32x4 ga = *(const f32x4*)(g2 + c), gb = *(const f32x4*)(g2 + c + 4);
                    f32x4 oa, ob;
#pragma unroll
                    for (int j = 0; j < 4; ++j) { oa[j] = yv[i * 8 + j] * r2 * ga[j]; ob[j] = yv[i * 8 + 4 + j] * r2 * gb[j]; }
                    *(u32x4*)(h2 + (size_t)rows[rr] * 2048 + c) = pk8(oa, ob);
                }
            }
        }
    }
}
DI void conv_act(const bf16_t* u, const float* cw, const float* cb, bf16_t* act, int wv) {
    constexpr int CG = DFF / 8, TG = MC / 16;
    const int total = CG * TG;
    for (int task = opq_s(blockIdx.x) * NT + opq_v(TIDX); task < total; task += gridDim.x * NT) {
        const int cgp = task % CG, tg = task / CG, c = cgp * 8, r0 = tg * 16;
        float w[2][3][8], b[2][8];
#pragma unroll
        for (int hv = 0; hv < 2; ++hv) {
#pragma unroll
            for (int k = 0; k < 3; ++k) {
                const f32x4 a0 = *(const f32x4*)(cw + (size_t)k * UPC + hv * DFF + c), a1 = *(const f32x4*)(cw + (size_t)k * UPC + hv * DFF + c + 4);
#pragma unroll
                for (int j = 0; j < 4; ++j) { w[hv][k][j] = a0[j]; w[hv][k][4 + j] = a1[j]; }
            }
            const f32x4 b0 = *(const f32x4*)(cb + hv * DFF + c), b1 = *(const f32x4*)(cb + hv * DFF + c + 4);
#pragma unroll
            for (int j = 0; j < 4; ++j) { b[hv][j] = b0[j]; b[hv][4 + j] = b1[j]; }
        }
        float p2[2][8], p1[2][8];
        const bool first = (r0 & 2047) == 0;
#pragma unroll
        for (int hv = 0; hv < 2; ++hv) {
            bf16x8 a = (bf16x8){0, 0, 0, 0, 0, 0, 0, 0}, bb = a;
            if (!first) { a = *(const bf16x8*)(u + (size_t)(r0 - 2) * UPC + hv * DFF + c); bb = *(const bf16x8*)(u + (size_t)(r0 - 1) * UPC + hv * DFF + c); }
#pragma unroll
            for (int j = 0; j < 8; ++j) { p2[hv][j] = bf2f((unsigned short)a[j]); p1[hv][j] = bf2f((unsigned short)bb[j]); }
        }
#pragma unroll 4
        for (int i = 0; i < 16; ++i) {
            float cv[2][8];
#pragma unroll
            for (int hv = 0; hv < 2; ++hv) {
                const bf16x8 a = *(const bf16x8*)(u + (size_t)(r0 + i) * UPC + hv * DFF + c);
#pragma unroll
                for (int j = 0; j < 8; ++j) {
                    const float x0 = bf2f((unsigned short)a[j]);
                    cv[hv][j] = b[hv][j] + w[hv][0][j] * p2[hv][j] + w[hv][1][j] * p1[hv][j] + w[hv][2][j] * x0;
                    p2[hv][j] = p1[hv][j]; p1[hv][j] = x0;
                }
            }
            f32x4 o0, o1;
#pragma unroll
            for (int j = 0; j < 8; ++j) {
                const float xg = cv[0][j];
                const float z = 0.7978845608028654f * (xg + 0.044715f * xg * xg * xg);
                const float r = xg * sigmoidf_(2.0f * z) * cv[1][j];
                if (j < 4) o0[j] = r; else o1[j - 4] = r;
            }
            st4(act + (size_t)(r0 + i) * DFF + c, o0); st4(act + (size_t)(r0 + i) * DFF + c + 4, o1);
        }
    }
}

DI int win_rowmap(int n) {
    if (n < 2560) return n;
    if (n < 2584) return 12800 + (n - 2560);
    if (n < 3608) {
        const int x = n - 2584, head = x >> 7, o = x & 127, hf = o >> 6, a = (o >> 4) & 3, f = (o >> 2) & 3, j = o & 3;
        return 2560 + head * 128 + 32 * a + 8 * f + 4 * hf + j;
    }
    return n - 24;
}
struct WJob { const float* src; bf16_t* dst; int K, N, k0, n0, mapw; };
constexpr int WT_IN = 32 * 51, WT_UP = 32 * 44, WT_DN = 88 * 8, WT_SQ = 32 * 8, WT_BR = 16 * 8, WT_C1 = 64, WT_C2 = 4;
constexpr int WT_TOTAL = WT_IN + WT_UP + WT_DN + WT_SQ + 3 * WT_BR + WT_SQ + 2 * WT_C1 + 2 * WT_C2;
DI WJob wjob(KP& P, int t) {
    WJob j; int ntn; j.mapw = 0;
    unsigned char* w = P.ws;
    if (t < WT_IN) { j.src = P.in[2]; j.dst = (bf16_t*)(w + O_WIN); j.K = 2048; j.N = IN_COLS; ntn = 51; j.mapw = 1; }
    else if ((t -= WT_IN) < WT_UP) { j.src = P.in[15]; j.dst = (bf16_t*)(w + O_WUP); j.K = 2048; j.N = UPC; ntn = 44; j.mapw = 2; }
    else if ((t -= WT_UP) < WT_DN) { j.src = P.in[18]; j.dst = (bf16_t*)(w + O_WDN); j.K = DFF; j.N = 2048; ntn = 8; }
    else if ((t -= WT_DN) < WT_SQ) { j.src = P.in[14]; j.dst = (bf16_t*)(w + O_WO); j.K = 2048; j.N = 2048; ntn = 8; }
    else if ((t -= WT_SQ) < WT_BR) { j.src = P.in[11]; j.dst = (bf16_t*)(w + O_WBR); j.K = 1024; j.N = 2048; ntn = 8; }
    else if ((t -= WT_BR) < WT_BR) { j.src = P.in[12]; j.dst = (bf16_t*)(w + O_WBR) + (size_t)2048 * 1024; j.K = 1024; j.N = 2048; ntn = 8; }
    else if ((t -= WT_BR) < WT_BR) { j.src = P.in[13]; j.dst = (bf16_t*)(w + O_WBR) + 2 * (size_t)2048 * 1024; j.K = 1024; j.N = 2048; ntn = 8; }
    else if ((t -= WT_BR) < WT_SQ) { j.src = P.in[10]; j.dst = (bf16_t*)(w + O_WMKV); j.K = 2048; j.N = 2048; ntn = 8; }
    else if ((t -= WT_SQ) < WT_C1) { j.src = P.in[4]; j.dst = (bf16_t*)(w + O_WC1); j.K = 4096; j.N = 256; ntn = 1; }
    else if ((t -= WT_C1) < WT_C1) { j.src = P.in[7]; j.dst = (bf16_t*)(w + O_WC1) + (size_t)256 * 4096; j.K = 4096; j.N = 256; ntn = 1; }
    else if ((t -= WT_C1) < WT_C2) { j.src = P.in[5]; j.dst = (bf16_t*)(w + O_WC2); j.K = 256; j.N = 128; ntn = 1; }
    else { t -= WT_C2; j.src = P.in[8]; j.dst = (bf16_t*)(w + O_WC2) + (size_t)256 * 256; j.K = 256; j.N = 128; ntn = 1; }
    j.k0 = (t / ntn) * 64; j.n0 = (t % ntn) * 256;
    return j;
}
DI void wjob_load(const WJob& j, f32x4 (&v)[8], int wv, int lane) {
    const int n = j.n0 + lane * 4;
#pragma unroll
    for (int i = 0; i < 8; ++i) v[i] = n < j.N ? *(const f32x4*)(j.src + (size_t)(j.k0 + wv + 8 * i) * j.N + n) : (f32x4){0.f, 0.f, 0.f, 0.f};
}
DI void zero_fill(unsigned char* p, size_t bytes, int wv) {
    for (size_t i = ((size_t)blockIdx.x * NT + TIDX) * 16; i < bytes; i += (size_t)gridDim.x * NT * 16) *(u32x4*)(p + i) = (u32x4){0u, 0u, 0u, 0u};
}
DI void phase_weights(KP& P, LAS unsigned char* lds, int wv) {
    LAS float* tile = (LAS float*)lds;
    const int lane = lane_now(), tid = wv * 64 + lane;
    zero_fill(P.ws + O_WIN + (size_t)IN_COLS * 2048 * 2, (size_t)(INP - IN_COLS) * 2048 * 2, wv);
    zero_fill(P.ws + O_WC2, 2 * (size_t)256 * 256 * 2, wv);
    for (int pb = blockIdx.x; pb < 256; pb += gridDim.x) {
        const int kv = pb >> 7, sl = pb & 127, jcol = tid & 255, hf = tid >> 8;
        const float* pe = P.in[kv ? 6 : 3]; const float* w1 = P.in[kv ? 7 : 4];
        float a = 0.f;
#pragma unroll
        for (int i = 0; i < 16; ++i) { const int ii = sl * 32 + hf * 16 + i; a += pe[ii] * w1[(size_t)ii * 256 + jcol]; }
        __syncthreads();
        tile[tid] = a;
        __syncthreads();
        if (tid < 256) ((float*)(P.ws + O_PEB + 4096))[(size_t)pb * 256 + tid] = tile[tid] + tile[tid + 256];
    }
    f32x4 v[8];
    int t = blockIdx.x;
    WJob j = wjob(P, t < WT_TOTAL - 2 * WT_C2 ? t : 0);
    if (t < WT_TOTAL - 2 * WT_C2) wjob_load(j, v, wv, lane);
    for (; t < WT_TOTAL - 2 * WT_C2; t += gridDim.x) {
        __syncthreads();
#pragma unroll
        for (int i = 0; i < 8; ++i) *(LAS f32x4*)(tile + (wv + 8 * i) * 260 + lane * 4) = v[i];
        __syncthreads();
        const WJob c = j;
        const int tn = t + gridDim.x;
        if (tn < WT_TOTAL - 2 * WT_C2) { j = wjob(P, tn); wjob_load(j, v, wv, lane); }
#pragma unroll
        for (int i = 0; i < 4; ++i) {
            const int ci = tid + NT * i, nl = ci & 255, kq = ci >> 8, n = c.n0 + nl;
            if (n < c.N) {
                u32x4 w;
#pragma unroll
                for (int e = 0; e < 4; ++e) w[e] = cvt_pk_bf16(tile[(kq * 8 + 2 * e) * 260 + nl], tile[(kq * 8 + 2 * e + 1) * 260 + nl]);
                int dr = n;
                if (c.mapw == 1) dr = win_rowmap(n);
                else if (c.mapw == 2) { const int hv = n >= DFF ? 1 : 0, chn = n - hv * DFF; dr = 256 * (chn >> 7) + 128 * hv + (chn & 127); }
                *(u32x4*)(c.dst + (size_t)dr * c.K + c.k0 + kq * 8) = w;
            }
        }
    }
    __syncthreads();
}
DI void phase_weights2(KP& P, LAS unsigned char* lds, int wv) {
    LAS float* tile = (LAS float*)lds;
    const int lane = lane_now(), tid = wv * 64 + lane;
    if (blockIdx.x == 0) {
        const int kv = tid >> 8, jcol = tid & 255;
        const float* pp = (const float*)(P.ws + O_PEB + 4096) + (size_t)kv * 128 * 256 + jcol;
        float s = 0.f;
        for (int sl = 0; sl < 128; ++sl) s += pp[(size_t)sl * 256];
        ((float*)(P.ws + O_PEB))[kv * 256 + jcol] = s;
    }
    for (int t = WT_TOTAL - 2 * WT_C2 + blockIdx.x; t < WT_TOTAL; t += gridDim.x) {
        const WJob c = wjob(P, t);
        f32x4 v[8];
        wjob_load(c, v, wv, lane);
        __syncthreads();
#pragma unroll
        for (int i = 0; i < 8; ++i) *(LAS f32x4*)(tile + (wv + 8 * i) * 260 + lane * 4) = v[i];
        __syncthreads();
#pragma unroll
        for (int i = 0; i < 4; ++i) {
            const int ci = tid + NT * i, nl = ci & 255, kq = ci >> 8, n = c.n0 + nl;
            if (n < c.N) {
                u32x4 w;
#pragma unroll
                for (int e = 0; e < 4; ++e) w[e] = cvt_pk_bf16(tile[(kq * 8 + 2 * e) * 260 + nl], tile[(kq * 8 + 2 * e + 1) * 260 + nl]);
                *(u32x4*)(c.dst + (size_t)n * c.K + c.k0 + kq * 8) = w;
            }
        }
    }
    __syncthreads();
}

DI KP* lp(KP* p) { asm volatile("" : "+s"(p)); return p; }
__global__ void __launch_bounds__(NT, 2) fwd_megakernel(Params Parg) {
    extern __shared__ __attribute__((aligned(16))) unsigned char shm[];
    LAS unsigned char* lds = (LAS unsigned char*)shm;
    cg::grid_group grid = cg::this_grid();
    const int wv = __builtin_amdgcn_readfirstlane((int)(threadIdx.x >> 6));
    KP* kp = (KP*)__builtin_amdgcn_kernarg_segment_ptr();
#define P (*lp(kp))
#define WSP (lp(kp)->ws)
    const int G = gridDim.x, bid = blockIdx.x;
    pg8::StaticOrder S;
    LAS unsigned* bst = (LAS unsigned*)(lds + LDS_PHASE);
    if (TIDX == 0) { const unsigned xcc = xcc_id(); bst[0] = xcc; bst[3] = 0u;
        __hip_atomic_fetch_add((unsigned*)(WSP + O_BAR) + 64 * xcc, 1u, __ATOMIC_RELAXED, __HIP_MEMORY_SCOPE_AGENT); }

    phase_weights(P, lds, wv);
    rms_rows(P.in[0], P.in[19], (bf16_t*)(WSP + O_H), MC, wv);
    rms_rows(P.in[1], P.in[21], (bf16_t*)(WSP + O_MEMN), NB * MEML, wv);
    grid.sync();
    if (TIDX == 0) { unsigned nx = 0u; unsigned* w = (unsigned*)(WSP + O_BAR);
      for (int j = 0; j < 16; ++j) nx += __hip_atomic_load(w + 64 * j, __ATOMIC_RELAXED, __HIP_MEMORY_SCOPE_AGENT) != 0u ? 1u : 0u;
      bst[2] = nx; bst[1] = __hip_atomic_load(w + 64 * bst[0], __ATOMIC_RELAXED, __HIP_MEMORY_SCOPE_AGENT); }
    phase_weights2(P, lds, wv);

#pragma nounroll
    for (int ch = 0; ch < NCHUNK; ++ch) {
        const float* xin = P.in[0] + (size_t)ch * MC * DM;
        float* xout = P.out + (size_t)ch * MC * DM;
        { pg8::Gemm g{(const bf16_t*)(WSP + O_H), (const bf16_t*)(WSP + O_WIN), 2048, 2048, MC, INP, 2048};
          S.init(g.M, g.N, G, opq_s(bid)); pg8::gemm_phase(lds, g, S, EpiInProj{WSP}, wv); }
        { pg8::Gemm g{(const bf16_t*)(WSP + O_MEMN), (const bf16_t*)(WSP + O_WMKV), 2048, 2048, NB * MEML, 2048, 2048};
          S.init(g.M, g.N, G, (bid + 64) % G); pg8::gemm_phase(lds, g, S, EpiMemKV{(bf16_t*)(WSP + O_MK), (bf16_t*)(WSP + O_MVT)}, wv); }
        grid_barrier((unsigned*)(WSP + O_BAR), (LAS unsigned*)(lds + LDS_PHASE), wv);
        {
            unsigned* cdone = (unsigned*)(WSP + O_BAR) + 3072 + 64 * (4 + ch);
            unsigned nunits = 0u;
            if (opq_s(bid) < NB * 256 / 256) { pg8::Gemm g{(const bf16_t*)(WSP + O_KC), (const bf16_t*)(WSP + O_WC1), 2048, 4096, NB * 256, 256, 4096};
              S.init(g.M, g.N, G, opq_s(bid));
              pg8::gemm_phase(lds, g, S, EpiC1{(bf16_t*)(WSP + O_H1), (const float*)(WSP + O_PEB)}, wv);
              asm volatile("s_waitcnt vmcnt(0)" ::: "memory"); __syncthreads(); if (TIDX == 0) { __builtin_amdgcn_fence(__ATOMIC_ACQUIRE, "agent"); asm volatile("s_waitcnt vmcnt(0)" ::: "memory"); } __syncthreads();
              pg8::Gemm g2{(const bf16_t*)(WSP + O_H1), (const bf16_t*)(WSP + O_WC2), 256, 256, NB * 256, 256, 256};
              pg8::gemm_phase(lds, g2, S, EpiC2<0>{(bf16_t*)(WSP + O_KCMP)}, wv); }
            if ((opq_s(bid) + 128) % G < NB * 256 / 256) { pg8::Gemm g{(const bf16_t*)(WSP + O_VC), (const bf16_t*)(WSP + O_WC1) + (size_t)256 * 4096, 2048, 4096, NB * 256, 256, 4096};
              S.init(g.M, g.N, G, (bid + 128) % G);
              pg8::gemm_phase(lds, g, S, EpiC1{(bf16_t*)(WSP + O_H1) + (size_t)NB * 256 * 256, (const float*)(WSP + O_PEB) + 256}, wv);
              asm volatile("s_waitcnt vmcnt(0)" ::: "memory"); __syncthreads(); if (TIDX == 0) { __builtin_amdgcn_fence(__ATOMIC_ACQUIRE, "agent"); asm volatile("s_waitcnt vmcnt(0)" ::: "memory"); } __syncthreads();
              pg8::Gemm g2{(const bf16_t*)(WSP + O_H1) + (size_t)NB * 256 * 256, (const bf16_t*)(WSP + O_WC2) + (size_t)256 * 256, 256, 256, NB * 256, 256, 256};
              pg8::gemm_phase(lds, g2, S, EpiC2<1>{(bf16_t*)(WSP + O_VCMT)}, wv); }
            { const int cu = NB * 256 / 256, ck = opq_s(bid), cv = (ck + 128) % G;
              nunits = (ck < cu ? (unsigned)((cu - 1 - ck) / G + 1) : 0u) + (cv < cu ? (unsigned)((cu - 1 - cv) / G + 1) : 0u); }
            if (nunits != 0u) {
                asm volatile("s_waitcnt vmcnt(0)" ::: "memory");
                __syncthreads();
                if (TIDX == 0) { __builtin_amdgcn_fence(__ATOMIC_RELEASE, "agent"); asm volatile("s_waitcnt vmcnt(0)" ::: "memory");
                    __hip_atomic_fetch_add(cdone, nunits, __ATOMIC_RELAXED, __HIP_MEMORY_SCOPE_AGENT); }
            }
            bool nsa_ready = false;
            for (;;) {
                __syncthreads();
                if (TIDX == 0) bst[4] = __hip_atomic_fetch_add((unsigned*)(WSP + O_BAR) + 3072 + 64 * ch, 1u, __ATOMIC_RELAXED, __HIP_MEMORY_SCOPE_AGENT);
                __syncthreads();
                const int i = (int)bst[4];
                if (i >= 2 * NB * 4 * 16 + NB * 2 * 32) break;
                if (i < NB * 4 * 16) { const int bh = i & 31; ret_item(P, lds, bh >> 2, bh & 3, 15 - (i >> 5), wv); }
                else if (i < 2 * NB * 4 * 16) { const int k = i - NB * 4 * 16, bh = k & 31; mem_item(P, lds, bh >> 2, bh & 3, k >> 5, wv); }
                else {
                    if (!nsa_ready) {
                        if (TIDX == 0) { while (__hip_atomic_load(cdone, __ATOMIC_RELAXED, __HIP_MEMORY_SCOPE_AGENT) < 2u * (NB * 256 / 256)) __builtin_amdgcn_s_sleep(2);
                            __builtin_amdgcn_fence(__ATOMIC_ACQUIRE, "agent"); asm volatile("s_waitcnt vmcnt(0)" ::: "memory"); }
                        __syncthreads();
                        nsa_ready = true;
                    }
                    const int k = i - 2 * NB * 4 * 16, bgi = k & 15;
                    nsa_item2(P, lds, bgi >> 1, bgi & 1, 31 - (k >> 4), wv);
                }
            }
        }
        grid_barrier((unsigned*)(WSP + O_BAR), (LAS unsigned*)(lds + LDS_PHASE), wv);
        { pg8::Gemm g{(const bf16_t*)(WSP + O_YA), (const bf16_t*)(WSP + O_WBR), 1024, 1024, MC, 2048, 1024};
          S.init(g.M, g.N, G, opq_s(bid)); pg8::gemm_phase(lds, g, S, EpiMerge<1>{(bf16_t*)(WSP + O_H), (const bf16_t*)(WSP + O_BG), 0}, wv);
          g.A = (const bf16_t*)(WSP + O_YB); g.Bt = (const bf16_t*)(WSP + O_WBR) + (size_t)2048 * 1024;
          pg8::gemm_phase(lds, g, S, EpiMerge<0>{(bf16_t*)(WSP + O_H), (const bf16_t*)(WSP + O_BG), 2048}, wv);
          g.A = (const bf16_t*)(WSP + O_YC); g.Bt = (const bf16_t*)(WSP + O_WBR) + 2 * (size_t)2048 * 1024;
          pg8::gemm_phase(lds, g, S, EpiMerge<0>{(bf16_t*)(WSP + O_H), (const bf16_t*)(WSP + O_BG), 4096}, wv); }
        grid_barrier((unsigned*)(WSP + O_BAR), (LAS unsigned*)(lds + LDS_PHASE), wv);
        { pg8::Gemm g{(const bf16_t*)(WSP + O_H), (const bf16_t*)(WSP + O_WO), 2048, 2048, MC, 2048, 2048};
          S.init(g.M, g.N, G, opq_s(bid)); pg8::gemm_phase(lds, g, S, EpiStore{(bf16_t*)(WSP + O_MO), 2048}, wv); }
        grid_barrier((unsigned*)(WSP + O_BAR), (LAS unsigned*)(lds + LDS_PHASE), wv);
        resid_rows<1>(xin, nullptr, (const bf16_t*)(WSP + O_MO), P.in[20], P.in[22], nullptr, (bf16_t*)(WSP + O_YA), (bf16_t*)(WSP + O_H), MC, wv);
        grid_barrier((unsigned*)(WSP + O_BAR), (LAS unsigned*)(lds + LDS_PHASE), wv);
        { pg8::Gemm g{(const bf16_t*)(WSP + O_H), (const bf16_t*)(WSP + O_WUP), 2048, 2048, MC, UPC, 2048};
          S.init(g.M, g.N, G, opq_s(bid)); pg8::gemm_phase(lds, g, S, EpiUpConv{(bf16_t*)(WSP + O_ACT), P.in[16], P.in[17], (float*)(WSP + O_HU), (float*)(WSP + O_HF), (LAS float*)(lds + LDS_HALO)}, wv); }
        grid_barrier((unsigned*)(WSP + O_BAR), (LAS unsigned*)(lds + LDS_PHASE), wv);
        conv_fixup((const float*)(WSP + O_HU), (const float*)(WSP + O_HF), P.in[16], P.in[17], (bf16_t*)(WSP + O_ACT), wv);
        grid_barrier((unsigned*)(WSP + O_BAR), (LAS unsigned*)(lds + LDS_PHASE), wv);
        { pg8::Gemm g{(const bf16_t*)(WSP + O_ACT), (const bf16_t*)(WSP + O_WDN), DFF, DFF, MC, 2048, DFF};
          S.init(g.M, g.N, G, opq_s(bid)); pg8::gemm_phase(lds, g, S, EpiStore{(bf16_t*)(WSP + O_MO), 2048}, wv); }
        grid_barrier((unsigned*)(WSP + O_BAR), (LAS unsigned*)(lds + LDS_PHASE), wv);
        resid_rows<0>(nullptr, (const bf16_t*)(WSP + O_YA), (const bf16_t*)(WSP + O_MO), P.in[23], nullptr, xout, nullptr, nullptr, MC, wv);
        if (ch + 1 < NCHUNK) {
            rms_rows(P.in[0] + (size_t)(ch + 1) * MC * DM, P.in[19], (bf16_t*)(WSP + O_H), MC, wv);
            rms_rows(P.in[1] + (size_t)(ch + 1) * NB * MEML * DM, P.in[21], (bf16_t*)(WSP + O_MEMN), NB * MEML, wv);
            grid_barrier((unsigned*)(WSP + O_BAR), (LAS unsigned*)(lds + LDS_PHASE), wv);
        }
    }
}

#undef P
#undef WSP
extern "C" void kernel_launch(void* const* d_in, const int* in_sizes, int n_in, void* d_out, int out_size, void* d_ws, size_t ws_size, hipStream_t stream) {
    static int grid_blocks = 0;
    if (grid_blocks == 0) {
        if (n_in != 24 || ws_size < O_END) { fprintf(stderr, "kernel_launch: unexpected inputs (n_in %d, ws %zu, need %zu)\n", n_in, ws_size, (size_t)O_END); grid_blocks = -1; return; }
        int dev = 0, cus = 0, per_cu = 0;
        hipGetDevice(&dev);
        hipDeviceGetAttribute(&cus, hipDeviceAttributeMultiprocessorCount, dev);
        if (hipFuncSetAttribute((const void*)fwd_megakernel, hipFuncAttributeMaxDynamicSharedMemorySize, LDS_BYTES) != hipSuccess) { fprintf(stderr, "kernel_launch: hipFuncSetAttribute failed\n"); grid_blocks = -1; return; }
        if (hipOccupancyMaxActiveBlocksPerMultiprocessor(&per_cu, (const void*)fwd_megakernel, NT, LDS_BYTES) != hipSuccess || per_cu < 1) { fprintf(stderr, "kernel_launch: occupancy query failed (%d)\n", per_cu); per_cu = 1; (void)hipGetLastError(); }
        grid_blocks = cus * 1;
    }
    if (grid_blocks < 0) return;
    Params p{};
    for (int i = 0; i < 24; ++i) p.in[i] = (const float*)d_in[i];
    p.out = (float*)d_out; p.ws = (unsigned char*)d_ws;
    if (hipMemsetAsync((unsigned char*)d_ws + O_BAR, 0, 16384, stream) != hipSuccess) { fprintf(stderr, "kernel_launch: memset failed\n"); return; }
    void* args[] = {&p};
    hipError_t e = hipLaunchCooperativeKernel((const void*)fwd_megakernel, dim3(grid_blocks), dim3(NT), args, LDS_BYTES, stream);
    if (e != hipSuccess) fprintf(stderr, "cooperative launch failed: %s (grid %d)\n", hipGetErrorString(e), grid_blocks);
}
```

```cpp
#include <hip/hip_runtime.h>
#include <hip/hip_cooperative_groups.h>
#include <cstdio>
namespace cg = cooperative_groups;

#define LAS __attribute__((address_space(3)))
#define DI __device__ __forceinline__
typedef unsigned short bf16_t;
typedef short bf16x8 __attribute__((ext_vector_type(8)));
typedef short bf16x4 __attribute__((ext_vector_type(4)));
typedef float f32x4 __attribute__((ext_vector_type(4)));
typedef unsigned u32x4 __attribute__((ext_vector_type(4)));
typedef unsigned u32x2 __attribute__((ext_vector_type(2)));

constexpr int DM = 2048, SEQ = 2048, BATCH = 16, MEML = 256;
constexpr int NB = 8, NCHUNK = BATCH / NB, MC = NB * SEQ;
constexpr int IN_COLS = 12824, INP = 13056, DFF = 5632, UPC = 2 * DFF;
constexpr float EPS = 1e-6f, LOG2E_ = 1.4426950408889634f;
constexpr int NT = 512;
constexpr int LDS_PHASE = 141312, LDS_HALO = LDS_PHASE + 64, LDS_BYTES = LDS_HALO + 8192;

constexpr size_t O_WIN  = 0;
constexpr size_t O_WUP  = O_WIN  + (size_t)INP * 2048 * 2;
constexpr size_t O_WDN  = O_WUP  + (size_t)UPC * 2048 * 2;
constexpr size_t O_WO   = O_WDN  + (size_t)2048 * DFF * 2;
constexpr size_t O_WBR  = O_WO   + (size_t)2048 * 2048 * 2;
constexpr size_t O_WMKV = O_WBR  + 3 * (size_t)2048 * 1024 * 2;
constexpr size_t O_WC1  = O_WMKV + (size_t)2048 * 2048 * 2;
constexpr size_t O_WC2  = O_WC1  + 2 * (size_t)256 * 4096 * 2;
constexpr size_t O_PEB  = O_WC2  + 2 * (size_t)256 * 256 * 2;
constexpr size_t O_H    = O_PEB  + 4096 + 256 * 256 * 4;
constexpr size_t O_PROJ = O_H    + (size_t)MC * 2048 * 2;
constexpr size_t O_QA   = O_PROJ;
constexpr size_t O_KC   = O_QA   + (size_t)MC * 1024 * 2;
constexpr size_t O_VC   = O_KC   + (size_t)MC * 256 * 2;
constexpr size_t O_KS   = O_VC   + (size_t)MC * 256 * 2;
constexpr size_t O_KW   = O_KS   + (size_t)MC * 256 * 2;
constexpr size_t O_VST  = O_KW   + (size_t)MC * 256 * 2;
constexpr size_t O_VWT  = O_VST  + (size_t)MC * 256 * 2;
constexpr size_t O_GATE = O_VWT  + (size_t)MC * 256 * 2;
constexpr size_t O_RQ   = O_GATE + (size_t)MC * 24 * 4;
constexpr size_t O_RK   = O_RQ   + (size_t)MC * 512 * 2;
constexpr size_t O_RVT  = O_RK   + (size_t)MC * 512 * 2;
constexpr size_t O_RG   = O_RVT  + (size_t)MC * 1024 * 2;
constexpr size_t O_MQ   = O_RG   + (size_t)MC * 1024 * 2;
constexpr size_t O_BG   = O_MQ   + (size_t)MC * 1024 * 2;
constexpr size_t O_PROJ_END = O_BG + (size_t)MC * 6144 * 2;
constexpr size_t O_U    = O_PROJ;
static_assert(O_U + (size_t)MC * UPC * 2 <= O_PROJ_END, "u overlay");
constexpr size_t O_MEMN = O_PROJ_END;
constexpr size_t O_MK   = O_MEMN + (size_t)NB * 256 * 2048 * 2;
constexpr size_t O_MVT  = O_MK   + (size_t)NB * 256 * 1024 * 2;
constexpr size_t O_H1   = O_MVT  + (size_t)NB * 256 * 1024 * 2;
constexpr size_t O_KCMP = O_H1   + 2 * (size_t)NB * 256 * 256 * 2;
constexpr size_t O_VCMT = O_KCMP + (size_t)NB * 2 * 128 * 128 * 2;
constexpr size_t O_YA   = O_VCMT + (size_t)NB * 2 * 128 * 128 * 2;
constexpr size_t O_YB   = O_YA   + (size_t)MC * 1024 * 2;
constexpr size_t O_YC   = O_YB   + (size_t)MC * 1024 * 2;
constexpr size_t O_MO   = O_YC   + (size_t)MC * 1024 * 2;
constexpr size_t O_ACT  = O_MO   + (size_t)MC * 2048 * 2;
constexpr size_t O_BAR  = O_ACT  + (size_t)MC * DFF * 2;
constexpr size_t O_HU   = O_BAR  + 16384;
constexpr size_t O_HF   = O_HU   + (size_t)64 * 2 * UPC * 4;
constexpr size_t O_END  = O_HF   + (size_t)64 * 2 * UPC * 4;
static_assert(O_END <= ((size_t)1 << 30), "workspace");

struct Params { const float* in[24]; float* out; unsigned char* ws; };
typedef const __attribute__((address_space(4))) Params KP;

typedef float f32x2_ __attribute__((ext_vector_type(2)));
typedef __bf16 bf16x2_ __attribute__((ext_vector_type(2)));
DI unsigned cvt_pk_bf16(float lo, float hi) { const f32x2_ v = {lo, hi}; const bf16x2_ b = __builtin_convertvector(v, bf16x2_); return __builtin_bit_cast(unsigned, b); }
DI float bf2f(unsigned short b) { return __uint_as_float(((unsigned)b) << 16); }
DI void st4(bf16_t* p, f32x4 v) { u32x2 w; w.x = cvt_pk_bf16(v[0], v[1]); w.y = cvt_pk_bf16(v[2], v[3]); *(u32x2*)p = w; }
DI float sigmoidf_(float x) { return __builtin_amdgcn_rcpf(1.0f + __builtin_amdgcn_exp2f(-1.4426950408889634f * x)); }
DI int lane_now() { unsigned z = 0u; asm volatile("" : "+v"(z)); return (int)__builtin_amdgcn_mbcnt_hi(~0u, __builtin_amdgcn_mbcnt_lo(~0u, z)); }
#define TIDX (wv * 64 + lane_now())
DI int opq_v(int x) { asm volatile("" : "+v"(x)); return x; }
DI int opq_s(int x) { asm volatile("" : "+s"(x)); return x; }
DI float shx(float v, int lane, int m) { return __int_as_float(__builtin_amdgcn_ds_bpermute((lane ^ m) << 2, __float_as_int(v))); }
DI float shl(float v, int src) { return __int_as_float(__builtin_amdgcn_ds_bpermute(src << 2, __float_as_int(v))); }
DI float wave_sum(float v, int lane) {
#pragma unroll
    for (int o = 32; o > 0; o >>= 1) v += shx(v, lane, o);
    return v; }

DI unsigned xcc_id() { return (unsigned)__builtin_amdgcn_s_getreg((3 << 11) | 20) & 0xFu; }
DI void grid_barrier(unsigned* w, LAS unsigned* st, int wv) {
    asm volatile("s_waitcnt vmcnt(0) lgkmcnt(0)" ::: "memory");
    __syncthreads();
    if (TIDX == 0) {
        const unsigned xcc = st[0], nloc = st[1], nx = st[2], gen = st[3] + 1u;
        st[3] = gen;
        const unsigned old = __hip_atomic_fetch_add(w + 1024 + 64 * xcc, 1u, __ATOMIC_RELAXED, __HIP_MEMORY_SCOPE_AGENT);
        if (old + 1u == gen * nloc) {
            __builtin_amdgcn_fence(__ATOMIC_RELEASE, "agent");
            asm volatile("s_waitcnt vmcnt(0)" ::: "memory");
            __hip_atomic_fetch_add(w + 2048, 1u, __ATOMIC_RELAXED, __HIP_MEMORY_SCOPE_AGENT);
        }
        while (__hip_atomic_load(w + 2048, __ATOMIC_RELAXED, __HIP_MEMORY_SCOPE_AGENT) < gen * nx) __builtin_amdgcn_s_sleep(2);
        __builtin_amdgcn_fence(__ATOMIC_ACQUIRE, "agent");
        asm volatile("s_waitcnt vmcnt(0)" ::: "memory");
    }
    __syncthreads();
}

namespace pg8 {
constexpr int BM = 256, BK = 64, HALF = 128, HTB = HALF * BK * 2, STAGE_BYTES = 8 * HTB, NXCD = 8, WGM = 8;
DI int lds_byte(int r, int c) { const int st = (r >> 4) * 2 + (c >> 5), rr = r & 15, cc = c & 31, ob = rr * 64 + cc * 2; return st * 1024 + (ob ^ (((ob >> 9) & 1) << 5)); }
DI void stage_rc(int b, int& R, int& C) { const int st = b / 1024, sb = b % 1024, swz = sb ^ (((sb >> 9) & 1) << 5); R = (st >> 1) * 16 + swz / 64; C = (st & 1) * 32 + (swz % 64) / 2; }
DI int perm32(int rho) { const int n = rho >> 4, i = rho & 15; return 8 * (i >> 2) + 4 * n + (i & 3); }
struct Unit { int pm, pn; };
struct Gemm { const bf16_t* A; const bf16_t* Bt; int lda, ldb, M, N, K; };
struct StaticOrder {
    int nM, nN, nwg, G, c;
    DI void init(int M, int N, int G_, int c_) { nM = M / BM; nN = N / BM; nwg = nM * nN; G = G_; c = c_; }
    DI bool next(int i, Unit& u) const {
        const long L = (long)i * G + c; if (L >= nwg) return false;
        int wgid = (int)L; { const int q = nwg / NXCD, r = nwg % NXCD, xcd = wgid % NXCD, off = wgid / NXCD; wgid = (xcd < r ? xcd * (q + 1) : r * (q + 1) + (xcd - r) * q) + off; }
        const int nig = WGM * nN, gid = wgid / nig, fm = gid * WGM, gsz = (nM - fm) < WGM ? (nM - fm) : WGM;
        u.pm = fm + ((wgid % nig) % gsz); u.pn = (wgid % nig) / gsz; return true;
    }
};
template <class Epi>
DI void gemm_phase(LAS unsigned char* lds, const Gemm g, const StaticOrder& S, const Epi& E, int wv) {
    const int tid = opq_v(TIDX), wid = __builtin_amdgcn_readfirstlane(tid >> 6), lane = tid & 63, wr = wid >> 2, wc = wid & 3, fr = lane & 15, fq = lane >> 4;
    const int K = g.K, nt = K / BK;
    unsigned voffA[2], voffB[2];
#pragma unroll
    for (int i = 0; i < 2; ++i) { int R, C; stage_rc(tid * 16 + i * 8192, R, C); const int Rb = Epi::PERM ? ((R & ~31) + perm32(R & 31)) : R;
        voffA[i] = (unsigned)(R * g.lda + C) * 2u; voffB[i] = (unsigned)(Rb * g.ldb + C) * 2u; }
    const size_t kstep = (size_t)(BK * 2);
    const size_t hstepA = (size_t)HALF * g.lda * 2, hstepB = (size_t)HALF * g.ldb * 2;
    const size_t tstepA = 2 * hstepA, tstepB = 2 * hstepB;
    const unsigned ldsw = (unsigned)wid * 1024u;
    const int aoff = lds_byte(wr * 64 + fr, fq * 8), boff = lds_byte(wc * 32 + fr, fq * 8);
#define PG8_SA(b, h) (((b) * 2 + (h)) * HTB)
#define PG8_SB(b, h) ((4 + (b) * 2 + (h)) * HTB)
#define PG8_STAGE(bufoff, gbase, voff) do { _Pragma("unroll") for (int _i = 0; _i < 2; ++_i) \
        __builtin_amdgcn_global_load_lds((const unsigned*)((const char*)(gbase) + (voff)[_i]), (LAS unsigned*)(lds + (bufoff) + ldsw + _i * 8192), 16, 0, 0); } while (0)
#define PG8_LDA(dst, b, h) do { _Pragma("unroll") for (int m = 0; m < 4; ++m) _Pragma("unroll") for (int k = 0; k < 2; ++k) dst[m][k] = *(const LAS bf16x8*)(lds + PG8_SA(b, h) + aoff + m * 2048 + k * 1024); } while (0)
#define PG8_LDB(dst, b, h) do { _Pragma("unroll") for (int n = 0; n < 2; ++n) _Pragma("unroll") for (int k = 0; k < 2; ++k) dst[n][k] = *(const LAS bf16x8*)(lds + PG8_SB(b, h) + boff + n * 2048 + k * 1024); } while (0)
#define PG8_MMA(ai, bj, At, Bt) do { __builtin_amdgcn_s_setprio(1); _Pragma("unroll") for (int m = 0; m < 4; ++m) _Pragma("unroll") for (int n = 0; n < 2; ++n) _Pragma("unroll") for (int k = 0; k < 2; ++k) \
        acc[ai][bj][m][n] = __builtin_amdgcn_mfma_f32_16x16x32_bf16(Bt[n][k], At[m][k], acc[ai][bj][m][n], 0, 0, 0); __builtin_amdgcn_s_setprio(0); } while (0)
#define PG8_WAIT_V(n) asm volatile("s_waitcnt vmcnt(" #n ")" ::: "memory")
#define PG8_WAIT_L(n) asm volatile("s_waitcnt lgkmcnt(" #n ")" ::: "memory")
#define PG8_BAR __builtin_amdgcn_s_barrier()
#define PG8_SCHED __builtin_amdgcn_sched_barrier(0)
    Unit cur, nxt; int ui = 0;
    if (!S.next(0, cur)) return;
    f32x4 acc[2][2][4][2];
#pragma unroll
    for (int a = 0; a < 2; ++a)
#pragma unroll
        for (int b = 0; b < 2; ++b)
#pragma unroll
            for (int m = 0; m < 4; ++m)
#pragma unroll
                for (int n = 0; n < 2; ++n) acc[a][b][m][n] = (f32x4){0.f, 0.f, 0.f, 0.f};
    bf16x8 At[4][2], B0[2][2], B1[2][2];
    const char* cA = (const char*)g.A + (size_t)cur.pm * tstepA; const char* cB = (const char*)g.Bt + (size_t)cur.pn * tstepB;
    PG8_STAGE(PG8_SB(0, 0), cB, voffB); PG8_STAGE(PG8_SA(0, 0), cA, voffA); PG8_STAGE(PG8_SB(0, 1), cB + hstepB, voffB); PG8_STAGE(PG8_SA(0, 1), cA + hstepA, voffA);
    if (wr == 1) PG8_BAR;
    PG8_WAIT_V(4); PG8_BAR;
    PG8_STAGE(PG8_SB(1, 0), cB + kstep, voffB); PG8_STAGE(PG8_SA(1, 0), cA + kstep, voffA); PG8_STAGE(PG8_SB(1, 1), cB + hstepB + kstep, voffB);
    PG8_WAIT_V(6); PG8_BAR;
    for (;;) {
        const bool has_next = S.next(ui + 1, nxt);
        const char* nA = has_next ? (const char*)g.A + (size_t)nxt.pm * tstepA : cA; const char* nB = has_next ? (const char*)g.Bt + (size_t)nxt.pn * tstepB : cB;
        for (int t = 0; t < nt; t += 2) {
            const bool last = (t == nt - 2);
            const char* a1 = cA + (size_t)(t + 1) * kstep;
            const char* a2 = last ? nA : cA + (size_t)(t + 2) * kstep; const char* b2 = last ? nB : cB + (size_t)(t + 2) * kstep;
            const char* a3 = a2 + kstep; const char* b3 = b2 + kstep;
            PG8_LDB(B0, 0, 0); PG8_SCHED; PG8_LDA(At, 0, 0); PG8_STAGE(PG8_SA(1, 1), a1 + hstepA, voffA);
            PG8_WAIT_L(8); PG8_BAR; PG8_WAIT_L(0); PG8_MMA(0, 0, At, B0); PG8_BAR; PG8_SCHED;
            PG8_LDB(B1, 0, 1); PG8_STAGE(PG8_SB(0, 0), b2, voffB);
            PG8_BAR; PG8_WAIT_L(0); PG8_MMA(0, 1, At, B1); PG8_BAR;
            PG8_LDA(At, 0, 1); PG8_STAGE(PG8_SA(0, 0), a2, voffA);
            PG8_BAR; PG8_WAIT_L(0); PG8_MMA(1, 0, At, B0); PG8_BAR; PG8_SCHED;
            PG8_STAGE(PG8_SB(0, 1), b2 + hstepB, voffB);
            PG8_WAIT_V(6); PG8_BAR; PG8_MMA(1, 1, At, B1); PG8_BAR;
            PG8_LDB(B0, 1, 0); PG8_SCHED; PG8_LDA(At, 1, 0); PG8_STAGE(PG8_SA(0, 1), a2 + hstepA, voffA);
            PG8_WAIT_L(8); PG8_BAR; PG8_WAIT_L(0); PG8_MMA(0, 0, At, B0); PG8_BAR; PG8_SCHED;
            PG8_LDB(B1, 1, 1); PG8_STAGE(PG8_SB(1, 0), b3, voffB);
            PG8_BAR; PG8_WAIT_L(0); PG8_MMA(0, 1, At, B1); PG8_BAR;
            PG8_LDA(At, 1, 1); PG8_STAGE(PG8_SA(1, 0), a3, voffA);
            PG8_BAR; PG8_WAIT_L(0); PG8_MMA(1, 0, At, B0); PG8_BAR; PG8_SCHED;
            PG8_STAGE(PG8_SB(1, 1), b3 + hstepB, voffB);
            PG8_WAIT_V(6); PG8_BAR; PG8_MMA(1, 1, At, B1); PG8_BAR;
        }
        E(acc, cur, wr, wc, fr, fq);
        if (!has_next) break;
#pragma unroll
        for (int a = 0; a < 2; ++a)
#pragma unroll
            for (int b = 0; b < 2; ++b)
#pragma unroll
                for (int m = 0; m < 4; ++m)
#pragma unroll
                    for (int n = 0; n < 2; ++n) acc[a][b][m][n] = (f32x4){0.f, 0.f, 0.f, 0.f};
        cur = nxt; cA = nA; cB = nB; ++ui;
    }
    PG8_WAIT_V(0);
    if (wr == 0) PG8_BAR;
    PG8_BAR;
#undef PG8_SA
#undef PG8_SB
#undef PG8_STAGE
#undef PG8_LDA
#undef PG8_LDB
#undef PG8_MMA
#undef PG8_WAIT_V
#undef PG8_WAIT_L
#undef PG8_BAR
#undef PG8_SCHED
}
}
using pg8::Unit;
typedef f32x4 Acc[2][2][4][2];

DI u32x4 pk8(f32x4 a, f32x4 b) { u32x4 w; w[0] = cvt_pk_bf16(a[0], a[1]); w[1] = cvt_pk_bf16(a[2], a[3]); w[2] = cvt_pk_bf16(b[0], b[1]); w[3] = cvt_pk_bf16(b[2], b[3]); return w; }
struct EpiStore {
    static constexpr bool PERM = true;
    bf16_t* O; int ldc;
    DI void operator()(const Acc& acc, const Unit& u, int wr, int wc, int fr, int fq) const {
#pragma unroll
        for (int ai = 0; ai < 2; ++ai)
#pragma unroll
            for (int m = 0; m < 4; ++m) {
                const size_t row = (size_t)u.pm * 256 + ai * 128 + wr * 64 + m * 16 + fr;
#pragma unroll
                for (int bj = 0; bj < 2; ++bj) *(u32x4*)(O + row * ldc + u.pn * 256 + bj * 128 + wc * 32 + fq * 8) = pk8(acc[ai][bj][m][0], acc[ai][bj][m][1]);
            }
    }
};
template <int FIRST> struct EpiMerge {
    static constexpr bool PERM = true;
    bf16_t* O; const bf16_t* gate; int goff;
    DI void operator()(const Acc& acc, const Unit& u, int wr, int wc, int fr, int fq) const {
#pragma unroll
        for (int ai = 0; ai < 2; ++ai)
#pragma unroll
            for (int m = 0; m < 4; ++m) {
                const size_t row = (size_t)u.pm * 256 + ai * 128 + wr * 64 + m * 16 + fr;
#pragma unroll
                for (int bj = 0; bj < 2; ++bj) {
                    const int col = u.pn * 256 + bj * 128 + wc * 32 + fq * 8;
                    const bf16x8 gv = *(const bf16x8*)(gate + row * 6144 + goff + col);
                    f32x4 v0 = acc[ai][bj][m][0], v1 = acc[ai][bj][m][1];
#pragma unroll
                    for (int j = 0; j < 4; ++j) { v0[j] *= bf2f((unsigned short)gv[j]); v1[j] *= bf2f((unsigned short)gv[4 + j]); }
                    if (!FIRST) { const bf16x8 ov = *(const bf16x8*)(O + row * 2048 + col);
#pragma unroll
                        for (int j = 0; j < 4; ++j) { v0[j] += bf2f((unsigned short)ov[j]); v1[j] += bf2f((unsigned short)ov[4 + j]); } }
                    *(u32x4*)(O + row * 2048 + col) = pk8(v0, v1);
                }
            }
    }
};
#define ROWLOOP _Pragma("unroll") for (int ai = 0; ai < 2; ++ai) _Pragma("unroll") for (int m = 0; m < 4; ++m)
#define BJLOOP _Pragma("unroll") for (int bj = 0; bj < 2; ++bj)
DI bf16_t bf1(float x) { return (bf16_t)(cvt_pk_bf16(x, 0.f) & 0xffffu); }
DI float dppx1(float x) { return __int_as_float(__builtin_amdgcn_update_dpp(0, __float_as_int(x), 0xB1, 0xf, 0xf, false)); }
DI float dppx2(float x) { return __int_as_float(__builtin_amdgcn_update_dpp(0, __float_as_int(x), 0x4E, 0xf, 0xf, false)); }
DI f32x4 quad_transpose(f32x4 v, int l) {
    const bool o1 = (l & 1) != 0, o2 = (l & 2) != 0;
    const float r0 = dppx1(o1 ? v[0] : v[1]), r1 = dppx1(o1 ? v[2] : v[3]);
    if (o1) { v[0] = r0; v[2] = r1; } else { v[1] = r0; v[3] = r1; }
    const float q0 = dppx2(o2 ? v[0] : v[2]), q1 = dppx2(o2 ? v[1] : v[3]);
    if (o2) { v[0] = q0; v[1] = q1; } else { v[2] = q0; v[3] = q1; }
    return v;
}
struct EpiMemKV {
    static constexpr bool PERM = true;
    bf16_t* mk; bf16_t* mvt;
    DI void operator()(const Acc& acc, const Unit& u, int wr, int wc, int fr, int fq) const {
        const int cb8 = wc * 32 + fq * 8;
        ROWLOOP { const int row = u.pm * 256 + ai * 128 + wr * 64 + m * 16 + fr, bl = row >> 8, mm = row & 255;
            BJLOOP { const int col = u.pn * 256 + bj * 128 + cb8;
                if (u.pn < 4) *(u32x4*)(mk + (size_t)row * 1024 + col) = pk8(acc[ai][bj][m][0], acc[ai][bj][m][1]);
                else {
#pragma unroll
                    for (int n = 0; n < 2; ++n)
#pragma unroll
                        for (int j = 0; j < 4; ++j) mvt[((size_t)bl * 1024 + (col - 1024 + n * 4 + j)) * 256 + mm] = bf1(acc[ai][bj][m][n][j]);
                } } }
    }
};
struct EpiC1 {
    static constexpr bool PERM = true;
    bf16_t* O; const float* peb;
    DI void operator()(const Acc& acc, const Unit& u, int wr, int wc, int fr, int fq) const {
        const int cb8 = wc * 32 + fq * 8;
        ROWLOOP { const size_t row = (size_t)u.pm * 256 + ai * 128 + wr * 64 + m * 16 + fr;
            BJLOOP { const int col = bj * 128 + cb8;
                f32x4 v0 = acc[ai][bj][m][0], v1 = acc[ai][bj][m][1];
#pragma unroll
                for (int j = 0; j < 4; ++j) { const float z0 = v0[j] + peb[col + j], z1 = v1[j] + peb[col + 4 + j]; v0[j] = z0 * sigmoidf_(z0); v1[j] = z1 * sigmoidf_(z1); }
                *(u32x4*)(O + row * 256 + col) = pk8(v0, v1); } }
    }
};
template <int ISV> struct EpiC2 {
    static constexpr bool PERM = true;
    bf16_t* O;
    DI void operator()(const Acc& acc, const Unit& u, int wr, int wc, int fr, int fq) const {
        const int cb8 = wc * 32 + fq * 8;
        ROWLOOP { const int row = u.pm * 256 + ai * 128 + wr * 64 + m * 16 + fr, bg = row >> 7, nn = row & 127;
            f32x4 v0 = acc[ai][0][m][0], v1 = acc[ai][0][m][1];
            if (nn == 127) { v0 = (f32x4){0.f, 0.f, 0.f, 0.f}; v1 = v0; }
            if (!ISV) *(u32x4*)(O + (size_t)row * 128 + cb8) = pk8(v0, v1);
            else {
#pragma unroll
                for (int j = 0; j < 4; ++j) { O[((size_t)bg * 128 + cb8 + j) * 128 + nn] = bf1(v0[j]); O[((size_t)bg * 128 + cb8 + 4 + j) * 128 + nn] = bf1(v1[j]); }
            } }
    }
};
struct EpiInProj {
    static constexpr bool PERM = true;
    unsigned char* ws;
    DI void operator()(const Acc& acc, const Unit& u, int wr, int wc, int fr, int fq) const {
        const int pn = u.pn;
        const int rbase = u.pm * 256 + wr * 64 + fr, cb8 = wc * 32 + fq * 8;
        if (pn < 4) {
            bf16_t* const qa = (bf16_t*)(ws + O_QA);
            ROWLOOP { const int row = rbase + ai * 128 + m * 16;
                BJLOOP *(u32x4*)(qa + (size_t)row * 1024 + pn * 256 + bj * 128 + cb8) = pk8(acc[ai][bj][m][0], acc[ai][bj][m][1]); }
        } else if (pn < 10) {
            const int br = (pn - 4) >> 1, isv = (pn - 4) & 1;
            if (!isv || br == 0) {
                bf16_t* base = (bf16_t*)(ws + (isv ? O_VC : (br == 0 ? O_KC : (br == 1 ? O_KS : O_KW))));
                ROWLOOP { const int row = rbase + ai * 128 + m * 16, bl = row >> 11, s = row & 2047;
                    BJLOOP *(u32x4*)(base + ((size_t)(bl * 2 + bj) * 2048 + s) * 128 + cb8) = pk8(acc[ai][bj][m][0], acc[ai][bj][m][1]); }
            } else {
                bf16_t* base = (bf16_t*)(ws + (br == 1 ? O_VST : O_VWT));
                const int l4 = fr & 3;
                ROWLOOP { const int row = rbase + ai * 128 + m * 16, bl = row >> 11, s4 = (row & 2047) - l4;
                    BJLOOP {
#pragma unroll
                        for (int n = 0; n < 2; ++n) st4(base + ((size_t)(bl * 2 + bj) * 128 + cb8 + n * 4 + l4) * 2048 + s4, quad_transpose(acc[ai][bj][m][n], l4)); } }
            }
        } else if (pn < 14) {
            const int isk = pn >= 12;
            bf16_t* base = (bf16_t*)(ws + (isk ? O_RK : O_RQ));
            const float sc = isk ? 0.08838834764831845f : 1.0f;
            float th[4];
#pragma unroll
            for (int j = 0; j < 4; ++j) th[j] = 1.0f / exp2f(13.287712379549449f * (float)(16 * wc + 4 * fq + j) * (1.0f / 63.0f));
            ROWLOOP { const int row = rbase + ai * 128 + m * 16, s = row & 2047;
                float sn[4], cs[4];
#pragma unroll
                for (int j = 0; j < 4; ++j) {
                    const float a = (float)s * th[j];
                    const float kq = rintf(a * 0.15915494309189535f);
                    float r = fmaf(-kq, 6.28125f, a); r = fmaf(-kq, 1.9353071795864769e-3f, r);
                    sn[j] = __sinf(r); cs[j] = __cosf(r);
                }
                BJLOOP {
                    const int head = ((pn - 10) & 1) * 2 + bj;
                    const f32x4 x1 = acc[ai][bj][m][0], x2 = acc[ai][bj][m][1];
                    f32x4 o1, o2;
#pragma unroll
                    for (int j = 0; j < 4; ++j) { o1[j] = (x1[j] * cs[j] - x2[j] * sn[j]) * sc; o2[j] = (x2[j] * cs[j] + x1[j] * sn[j]) * sc; }
                    *(u32x4*)(base + (size_t)row * 512 + head * 128 + cb8) = pk8(o1, o2);
                } }
        } else if (pn < 18) {
            bf16_t* base = (bf16_t*)(ws + O_RVT);
            const int l4 = fr & 3;
            ROWLOOP { const int row = rbase + ai * 128 + m * 16, bl = row >> 11, s4 = (row & 2047) - l4;
                BJLOOP { const int col = (pn - 14) * 256 + bj * 128 + cb8;
#pragma unroll
                    for (int n = 0; n < 2; ++n) st4(base + ((size_t)bl * 1024 + col + n * 4 + l4) * 2048 + s4, quad_transpose(acc[ai][bj][m][n], l4)); } }
        } else if (pn < 22) {
            bf16_t* base = (bf16_t*)(ws + O_RG);
            ROWLOOP { const int row = rbase + ai * 128 + m * 16;
                BJLOOP { f32x4 v0 = acc[ai][bj][m][0], v1 = acc[ai][bj][m][1];
#pragma unroll
                    for (int j = 0; j < 4; ++j) { v0[j] = v0[j] * sigmoidf_(v0[j]); v1[j] = v1[j] * sigmoidf_(v1[j]); }
                    *(u32x4*)(base + (size_t)row * 1024 + (pn - 18) * 256 + bj * 128 + cb8) = pk8(v0, v1); } }
        } else if (pn < 26) {
            bf16_t* base = (bf16_t*)(ws + O_MQ);
            ROWLOOP { const int row = rbase + ai * 128 + m * 16;
                BJLOOP *(u32x4*)(base + (size_t)row * 1024 + (pn - 22) * 256 + bj * 128 + cb8) = pk8(acc[ai][bj][m][0], acc[ai][bj][m][1]); }
        } else if (pn < 50) {
            bf16_t* base = (bf16_t*)(ws + O_BG);
            ROWLOOP { const int row = rbase + ai * 128 + m * 16;
                BJLOOP { f32x4 v0 = acc[ai][bj][m][0], v1 = acc[ai][bj][m][1];
#pragma unroll
                    for (int j = 0; j < 4; ++j) { v0[j] = sigmoidf_(v0[j]); v1[j] = sigmoidf_(v1[j]); }
                    *(u32x4*)(base + (size_t)row * 6144 + (pn - 26) * 256 + bj * 128 + cb8) = pk8(v0, v1); } }
        } else {
            float* gt = (float*)(ws + O_GATE);
            ROWLOOP { const int row = rbase + ai * 128 + m * 16;
#pragma unroll
                for (int n = 0; n < 2; ++n) { const f32x4 v = acc[ai][0][m][n]; const int col = cb8 + n * 4;
#pragma unroll
                    for (int j = 0; j < 4; ++j) if (col + j < 24) gt[(size_t)row * 24 + col + j] = sigmoidf_(v[j]); } }
        }
    }
};

DI f32x4 bperm4(f32x4 v, int src) { f32x4 r;
#pragma unroll
    for (int j = 0; j < 4; ++j) r[j] = __int_as_float(__builtin_amdgcn_ds_bpermute(src << 2, __float_as_int(v[j]))); return r; }
DI float gelu_tanh(float x) { const float z = 0.7978845608028654f * (x + 0.044715f * x * x * x); return x * sigmoidf_(2.0f * z); }
typedef _Float16 h2_t __attribute__((ext_vector_type(2)));
DI h2_t pkh(float a, float b) { h2_t r; r[0] = (_Float16)a; r[1] = (_Float16)b; return r; }
DI h2_t h2_ror1(h2_t x) { return __builtin_bit_cast(h2_t, __builtin_amdgcn_update_dpp(0, __builtin_bit_cast(int, x), 0x121, 0xf, 0xf, false)); }
DI h2_t h2_ror2(h2_t x) { return __builtin_bit_cast(h2_t, __builtin_amdgcn_update_dpp(0, __builtin_bit_cast(int, x), 0x122, 0xf, 0xf, false)); }
DI h2_t h2_sel(bool c, h2_t a, h2_t b) { return __builtin_bit_cast(h2_t, c ? __builtin_bit_cast(int, a) : __builtin_bit_cast(int, b)); }
struct EpiUpConv {
    static constexpr bool PERM = false;
    bf16_t* act; const float* cw; const float* cb; float* hu; float* hf; LAS float* halo;
    DI void operator()(const Acc& acc, const Unit& u, int wr, int wc, int fr_in, int fq_in) const {
        const int fr = opq_v(fr_in), fq = opq_v(fq_in);
        const int cbase = wc * 32 + fq * 4;
        if (fr >= 14) {
#pragma unroll
            for (int ai = 0; ai < 2; ++ai)
#pragma unroll
                for (int bj = 0; bj < 2; ++bj)
#pragma unroll
                    for (int n = 0; n < 2; ++n) *(LAS f32x4*)(halo + ((2 * ai + wr) * 2 + (fr - 14)) * 256 + bj * 128 + n * 16 + cbase) = acc[ai][bj][3][n];
            if (wr == 1) {
#pragma unroll
                for (int bj = 0; bj < 2; ++bj)
#pragma unroll
                    for (int n = 0; n < 2; ++n) *(f32x4*)(hu + ((size_t)u.pm * 2 + (fr - 14)) * UPC + u.pn * 256 + bj * 128 + n * 16 + cbase) = acc[1][bj][3][n];
            }
        }
        if (wr == 0 && fr < 2) {
#pragma unroll
            for (int bj = 0; bj < 2; ++bj)
#pragma unroll
                for (int n = 0; n < 2; ++n) *(f32x4*)(hf + ((size_t)u.pm * 2 + fr) * UPC + u.pn * 256 + bj * 128 + n * 16 + cbase) = acc[0][bj][0][n];
        }
        asm volatile("s_waitcnt lgkmcnt(0)" ::: "memory");
        __builtin_amdgcn_s_barrier(); asm volatile("" ::: "memory");
        __builtin_amdgcn_s_barrier(); asm volatile("" ::: "memory");
        const bool seqstart = (u.pm & 7) == 0;
        const bool f1 = fr >= 1, f2 = fr >= 2, f0 = fr == 0;
        const h2_t K1 = pkh(-2.3022082f, -2.3022082f), K2 = pkh(-0.10294324f, -0.10294324f), ONE = pkh(1.0f, 1.0f);
#pragma unroll
        for (int n = 0; n < 2; ++n) {
            const int chb = u.pn * 128 + n * 16 + cbase;
            h2_t wg[2][4], wv_[2][4];
#pragma unroll
            for (int jh = 0; jh < 2; ++jh) {
#pragma unroll
                for (int k = 0; k < 3; ++k) { wg[jh][k] = pkh(cw[(size_t)k * UPC + chb + 2 * jh], cw[(size_t)k * UPC + chb + 2 * jh + 1]); wv_[jh][k] = pkh(cw[(size_t)k * UPC + DFF + chb + 2 * jh], cw[(size_t)k * UPC + DFF + chb + 2 * jh + 1]); }
                wg[jh][3] = pkh(cb[chb + 2 * jh], cb[chb + 2 * jh + 1]); wv_[jh][3] = pkh(cb[DFF + chb + 2 * jh], cb[DFF + chb + 2 * jh + 1]);
            }
#pragma unroll
            for (int ai = 0; ai < 2; ++ai) {
                const int q = 2 * ai + wr;
                h2_t p1g[2], p2g[2], p1v[2], p2v[2];
#pragma unroll
                for (int jh = 0; jh < 2; ++jh) { p1g[jh] = pkh(0.f, 0.f); p2g[jh] = p1g[jh]; p1v[jh] = p1g[jh]; p2v[jh] = p1g[jh]; }
                if (q > 0) {
                    const LAS float* hp = halo + ((q - 1) * 2) * 256 + n * 16 + cbase;
                    const f32x4 h2gf = *(const LAS f32x4*)hp, h1gf = *(const LAS f32x4*)(hp + 256), h2vf = *(const LAS f32x4*)(hp + 128), h1vf = *(const LAS f32x4*)(hp + 384);
#pragma unroll
                    for (int jh = 0; jh < 2; ++jh) {
                        const h2_t h2g = pkh(h2gf[2 * jh], h2gf[2 * jh + 1]), h1g = pkh(h1gf[2 * jh], h1gf[2 * jh + 1]), h2v = pkh(h2vf[2 * jh], h2vf[2 * jh + 1]), h1v = pkh(h1vf[2 * jh], h1vf[2 * jh + 1]);
                        p1g[jh] = h1g; p1v[jh] = h1v; p2g[jh] = h2_sel(f0, h2g, h1g); p2v[jh] = h2_sel(f0, h2v, h1v);
                    }
                }
#pragma unroll
                for (int m = 0; m < 4; ++m) {
                    u32x2 w;
#pragma unroll
                    for (int jh = 0; jh < 2; ++jh) {
                        const h2_t xg = pkh(acc[ai][0][m][n][jh * 2], acc[ai][0][m][n][jh * 2 + 1]), xv = pkh(acc[ai][1][m][n][jh * 2], acc[ai][1][m][n][jh * 2 + 1]);
                        const h2_t r1g = h2_ror1(xg), r2g = h2_ror2(xg), r1v = h2_ror1(xv), r2v = h2_ror2(xv);
                        const h2_t a1g = h2_sel(f1, r1g, p1g[jh]), a2g = h2_sel(f2, r2g, p2g[jh]), a1v = h2_sel(f1, r1v, p1v[jh]), a2v = h2_sel(f2, r2v, p2v[jh]);
                        const h2_t yg = wg[jh][3] + wg[jh][0] * a2g + wg[jh][1] * a1g + wg[jh][2] * xg;
                        const h2_t yv = wv_[jh][3] + wv_[jh][0] * a2v + wv_[jh][1] * a1v + wv_[jh][2] * xv;
                        const h2_t arg = yg * (K1 + K2 * (yg * yg));
                        const h2_t d = __builtin_elementwise_exp2(arg) + ONE;
                        h2_t r; r[0] = __builtin_amdgcn_rcph(d[0]); r[1] = __builtin_amdgcn_rcph(d[1]);
                        const h2_t o = (yg * r) * yv;
                        p1g[jh] = r1g; p2g[jh] = r2g; p1v[jh] = r1v; p2v[jh] = r2v;
                        const unsigned pk = cvt_pk_bf16((float)o[0], (float)o[1]);
                        if (jh == 0) w.x = pk; else w.y = pk;
                    }
                    const size_t row = (size_t)u.pm * 256 + ai * 128 + wr * 64 + m * 16 + fr;
                    if (!(q == 0 && m == 0 && fr < 2 && !seqstart)) *(u32x2*)(act + row * DFF + chb) = w;
                }
            }
        }
    }
};
DI void conv_fixup(const float* hu, const float* hf, const float* cw, const float* cb, bf16_t* act, int wv) {
    constexpr int CG4 = DFF / 4;
    for (int task = opq_s(blockIdx.x) * NT + opq_v(TIDX); task < (MC / 256) * CG4; task += gridDim.x * NT) {
        const int cgp = task % CG4, pm = task / CG4;
        if ((pm & 7) == 0) continue;
        const int ch = cgp * 4, colg = 256 * (ch >> 7) + (ch & 127);
        f32x4 y0[2], y1[2];
#pragma unroll
        for (int hv = 0; hv < 2; ++hv) {
            const int col = colg + 128 * hv, cc = ch + hv * DFF;
            const f32x4 a0 = *(const f32x4*)(hu + ((size_t)(pm - 1) * 2 + 0) * UPC + col), a1 = *(const f32x4*)(hu + ((size_t)(pm - 1) * 2 + 1) * UPC + col);
            const f32x4 f0 = *(const f32x4*)(hf + ((size_t)pm * 2 + 0) * UPC + col), f1 = *(const f32x4*)(hf + ((size_t)pm * 2 + 1) * UPC + col);
            const f32x4 w0 = *(const f32x4*)(cw + cc), w1 = *(const f32x4*)(cw + UPC + cc), w2 = *(const f32x4*)(cw + 2 * UPC + cc), b = *(const f32x4*)(cb + cc);
            y0[hv] = b + w0 * a0 + w1 * a1 + w2 * f0;
            y1[hv] = b + w0 * a1 + w1 * f0 + w2 * f1;
        }
        f32x4 o0, o1;
#pragma unroll
        for (int j = 0; j < 4; ++j) { o0[j] = gelu_tanh(y0[0][j]) * y0[1][j]; o1[j] = gelu_tanh(y1[0][j]) * y1[1][j]; }
        st4(act + ((size_t)pm * 256 + 0) * DFF + ch, o0);
        st4(act + ((size_t)pm * 256 + 1) * DFF + ch, o1);
    }
}

constexpr int A_KS = 0, A_VT = 34816;
constexpr int N_STG = 35840, N_K = 0, N_V = 17408;
constexpr int A_BIAS = 2 * N_STG, A_PART = A_BIAS + 3136, A_EDGE = A_PART + 16384, A_SELM = A_EDGE + 16384;
constexpr int R_STG = 54272, R_K = 0, R_V = 17408;
static_assert(2 * R_STG <= LDS_PHASE, "retention LDS");
static_assert(A_SELM + 256 <= LDS_PHASE, "attention LDS");

template <int ROWBYTES, int NROWS>
DI void g2r(u32x4 (&r)[(ROWBYTES / 16) * NROWS / NT], const bf16_t* src, size_t src_stride, int tid) {
    constexpr int CPR = ROWBYTES / 16, N = CPR * NROWS / NT;
    static_assert(CPR * NROWS % NT == 0, "tile chunks");
#pragma unroll
    for (int i = 0; i < N; ++i) { const int c = i * NT + tid, rr = c / CPR, cc = c % CPR; r[i] = *(const u32x4*)((const char*)(src + (size_t)rr * src_stride) + cc * 16); }
}
template <int ROWBYTES, int NROWS, int LSTRIDE>
DI void r2l(const u32x4 (&r)[(ROWBYTES / 16) * NROWS / NT], LAS unsigned char* dst, int tid) {
    constexpr int CPR = ROWBYTES / 16, N = CPR * NROWS / NT;
#pragma unroll
    for (int i = 0; i < N; ++i) { const int c = i * NT + tid, rr = c / CPR, cc = c % CPR; *(LAS u32x4*)(dst + rr * LSTRIDE + cc * 16) = r[i]; }
}
template <int DQK>
DI void qk_tile(const LAS unsigned char* Ks, int fr, int fq, const bf16x8 (&qf)[DQK / 32], f32x4 (&s)[4]) {
    constexpr int KSTR = (DQK + 8) * 2, NK = DQK / 32;
    const LAS unsigned char* base = Ks + fr * KSTR + fq * 16;
#pragma unroll
    for (int nt = 0; nt < 4; ++nt) s[nt] = (f32x4){0.f, 0.f, 0.f, 0.f};
#pragma unroll
    for (int h = 0; h < NK / 4; ++h) {
        bf16x8 kf[4][4];
#pragma unroll
        for (int nt = 0; nt < 4; ++nt)
#pragma unroll
            for (int kk = 0; kk < 4; ++kk) kf[nt][kk] = *(const LAS bf16x8*)(base + nt * 16 * KSTR + (h * 4 + kk) * 64);
#pragma unroll
        for (int kk = 0; kk < 4; ++kk)
#pragma unroll
            for (int nt = 0; nt < 4; ++nt) s[nt] = __builtin_amdgcn_mfma_f32_16x16x32_bf16(kf[nt][kk], qf[h * 4 + kk], s[nt], 0, 0, 0);
    }
}
template <int DV, int VSTR>
DI void pv_tile(const LAS unsigned char* Vt, int fr, int fq, const f32x4 (&p)[4], f32x4 (&o)[DV / 16]) {
    bf16x8 pf[2];
#pragma unroll
    for (int ks = 0; ks < 2; ++ks) {
        u32x4 pw; pw[0] = cvt_pk_bf16(p[2 * ks][0], p[2 * ks][1]); pw[1] = cvt_pk_bf16(p[2 * ks][2], p[2 * ks][3]);
        pw[2] = cvt_pk_bf16(p[2 * ks + 1][0], p[2 * ks + 1][1]); pw[3] = cvt_pk_bf16(p[2 * ks + 1][2], p[2 * ks + 1][3]);
        pf[ks] = __builtin_bit_cast(bf16x8, pw);
    }
    const LAS unsigned char* base = Vt + fr * VSTR + fq * 8;
#pragma unroll
    for (int g = 0; g < DV / 64; ++g) {
        bf16x4 lo[4][2], hi[4][2];
#pragma unroll
        for (int d4 = 0; d4 < 4; ++d4)
#pragma unroll
            for (int ks = 0; ks < 2; ++ks) {
                const LAS unsigned char* q = base + (g * 4 + d4) * 16 * VSTR + ks * 64;
                lo[d4][ks] = *(const LAS bf16x4*)q; hi[d4][ks] = *(const LAS bf16x4*)(q + 32);
            }
#pragma unroll
        for (int ks = 0; ks < 2; ++ks)
#pragma unroll
            for (int d4 = 0; d4 < 4; ++d4) {
                const bf16x8 vf = __builtin_shufflevector(lo[d4][ks], hi[d4][ks], 0, 1, 2, 3, 4, 5, 6, 7);
                o[g * 4 + d4] = __builtin_amdgcn_mfma_f32_16x16x32_bf16(vf, pf[ks], o[g * 4 + d4], 0, 0, 0);
            }
    }
}
template <bool CHECK>
DI float softmax_step(f32x4 (&s)[4], float& m, float& l, int lane) {
    f32x4 mv = s[0];
#pragma unroll
    for (int nt = 1; nt < 4; ++nt)
#pragma unroll
        for (int j = 0; j < 4; ++j) mv[j] = fmaxf(mv[j], s[nt][j]);
    float mt = fmaxf(fmaxf(mv[0], mv[1]), fmaxf(mv[2], mv[3]));
    mt = fmaxf(mt, shx(mt, lane, 16)); mt = fmaxf(mt, shx(mt, lane, 32));
    const float mn = fmaxf(m, mt), alpha = __builtin_amdgcn_exp2f(m - mn);
    f32x4 ps = (f32x4){0.f, 0.f, 0.f, 0.f};
#pragma unroll
    for (int nt = 0; nt < 4; ++nt) {
        const f32x4 d = s[nt] - mn;
        f32x4 pv;
#pragma unroll
        for (int j = 0; j < 4; ++j) { pv[j] = __builtin_amdgcn_exp2f(d[j]); if (CHECK) pv[j] = (s[nt][j] > -1e29f) ? pv[j] : 0.f; }
        s[nt] = pv; ps += pv;
    }
    m = mn; l = l * alpha + ((ps[0] + ps[1]) + (ps[2] + ps[3]));
    return alpha;
}
DI int t5_bucket(int n) {
    if (n < 16) return n;
    int b = 16 + (int)(logf((float)n * (1.0f / 16.0f)) / 2.0794415416798357f * 16.0f);
    return b > 31 ? 31 : b;
}

DI void nsa_item(KP& P, LAS unsigned char* lds, int bl, int g, int tt, int wv) {
    const int tid = opq_v(TIDX), wid = tid >> 6, lane = tid & 63, fr = lane & 15, fq = lane >> 4;
    const int hh = wid & 3, ts = wid >> 2, t0 = tt * 32, t = t0 + ts * 16 + fr, bgi = bl * 2 + g, H = g * 4 + hh;
    const size_t row = (size_t)bl * 2048 + t;
    LAS float* bias = (LAS float*)(lds + A_BIAS);
    LAS float* part = (LAS float*)(lds + A_PART);
    LAS float* edge = (LAS float*)(lds + A_EDGE);
    LAS unsigned* selm = (LAS unsigned*)(lds + A_SELM);
    const bf16_t* ksb = (const bf16_t*)(P.ws + O_KS) + (size_t)bgi * 2048 * 128;
    const bf16_t* kwb = (const bf16_t*)(P.ws + O_KW) + (size_t)bgi * 2048 * 128;
    const bf16_t* vsb = (const bf16_t*)(P.ws + O_VST) + (size_t)bgi * 128 * 2048;
    const bf16_t* vwb = (const bf16_t*)(P.ws + O_VWT) + (size_t)bgi * 128 * 2048;
    u32x4 rk[2], rv[2];
    __syncthreads();
    {
        u32x4 ck[4], cv[4];
        g2r<256, 128>(ck, (const bf16_t*)(P.ws + O_KCMP) + (size_t)bgi * 128 * 128, 128, tid);
        g2r<256, 128>(cv, (const bf16_t*)(P.ws + O_VCMT) + (size_t)bgi * 128 * 128, 128, tid);
        for (int i = tid; i < 4 * 193; i += NT) { const int h4 = i / 193, r = i % 193 - 64; bias[h4 * 196 + r + 64] = r < 0 ? -1e30f : P.in[9][t5_bucket(r) * 8 + g * 4 + h4] * 1.4426950408889634f; }
        r2l<256, 128, 272>(ck, lds, tid);
        r2l<256, 128, 272>(cv, lds + N_STG, tid);
    }
    g2r<256, 64>(rk, ksb, 128, tid);
    g2r<128, 128>(rv, vsb, 2048, tid);
    bf16x8 qf[4];
    { const bf16_t* qp = (const bf16_t*)(P.ws + O_QA) + row * 1024 + H * 128 + fq * 8;
#pragma unroll
      for (int kk = 0; kk < 4; ++kk) qf[kk] = *(const bf16x8*)(qp + kk * 32); }
    const float* gt = (const float*)(P.ws + O_GATE) + row * 24;
    const float g0 = gt[H], g1 = gt[8 + H], g2 = gt[16 + H];
    f32x4 y[8];
#pragma unroll
    for (int i = 0; i < 8; ++i) y[i] = (f32x4){0.f, 0.f, 0.f, 0.f};
    __syncthreads();
    {
        f32x4 sc[2][4];
        qk_tile<128>(lds, fr, fq, qf, sc[0]);
        qk_tile<128>(lds + 64 * 272, fr, fq, qf, sc[1]);
        const LAS float* bh = bias + hh * 196 + 64;
        float mx = -1e30f;
#pragma unroll
        for (int kt = 0; kt < 2; ++kt)
#pragma unroll
            for (int nt = 0; nt < 4; ++nt)
#pragma unroll
                for (int j = 0; j < 4; ++j) {
                    const int n = kt * 64 + nt * 16 + fq * 4 + j, rel = t - 16 * n - 31;
                    const int ri = rel < 0 ? 0 : (rel > 128 ? 128 : rel);
                    const float v = rel >= 0 ? sc[kt][nt][j] * (0.08838834764831845f * 1.4426950408889634f) + bh[ri] : -1e30f;
                    sc[kt][nt][j] = v; mx = fmaxf(mx, v);
                }
        mx = fmaxf(mx, shx(mx, lane, 16)); mx = fmaxf(mx, shx(mx, lane, 32));
        float ls = 0.f;
#pragma unroll
        for (int kt = 0; kt < 2; ++kt)
#pragma unroll
            for (int nt = 0; nt < 4; ++nt)
#pragma unroll
                for (int j = 0; j < 4; ++j) { const float pv = sc[kt][nt][j] > -1e29f ? __builtin_amdgcn_exp2f(sc[kt][nt][j] - mx) : 0.f; sc[kt][nt][j] = pv; ls += pv; }
        ls += shx(ls, lane, 16); ls += shx(ls, lane, 32);
        const float inv = 1.0f / fmaxf(ls, 1e-30f);
#pragma unroll
        for (int kt = 0; kt < 2; ++kt)
#pragma unroll
            for (int nt = 0; nt < 4; ++nt) {
                sc[kt][nt] *= inv;
                const int jidx = kt * 16 + nt * 4 + fq, o = (hh * 32 + ts * 16 + fr) * 32 + jidx;
                part[o] = (sc[kt][nt][0] + sc[kt][nt][1]) + (sc[kt][nt][2] + sc[kt][nt][3]);
                edge[o] = sc[kt][nt][3];
            }
        f32x4 o[8];
#pragma unroll
        for (int i = 0; i < 8; ++i) o[i] = (f32x4){0.f, 0.f, 0.f, 0.f};
        pv_tile<128, 272>(lds + N_STG, fr, fq, sc[0], o);
        pv_tile<128, 272>(lds + N_STG + 128, fr, fq, sc[1], o);
#pragma unroll
        for (int i = 0; i < 8; ++i) y[i] += o[i] * g0;
    }
    __syncthreads();
#pragma unroll
    for (int pass = 0; pass < 2; ++pass) {
        const int tok = pass * 16 + wid * 2 + (lane >> 5), j = lane & 31;
        float v = 0.f;
#pragma unroll
        for (int h4 = 0; h4 < 4; ++h4) { const int o = (h4 * 32 + tok) * 32 + j; v += part[o] + (j > 0 ? edge[o - 1] : 0.f); }
        const int cur = (t0 + tok) >> 6;
        if (j == 0 || (cur - j >= 0 && cur - j < 2)) v = 1e4f;
        if (j > cur) v = -1.0f;
        int rank = 0;
#pragma unroll
        for (int i = 0; i < 32; ++i) { const float vi = shl(v, (lane & 32) + i); rank += (vi > v || (vi == v && i < j)) ? 1 : 0; }
        const unsigned long long bal = __ballot(rank < 16);
        if (j == 0) selm[tok] = (unsigned)((lane & 32) ? (bal >> 32) : (bal & 0xffffffffull));
    }
    __syncthreads();
    unsigned um = selm[lane & 31];
#pragma unroll
    for (int o = 16; o > 0; o >>= 1) um |= (unsigned)__builtin_amdgcn_ds_bpermute((lane ^ o) << 2, (int)um);
    um = (unsigned)__builtin_amdgcn_readfirstlane((int)um);
    const unsigned mysel = selm[ts * 16 + fr];
    const int kt_hi = t0 >> 6, kt_lo_w = (t0 - 511) > 0 ? ((t0 - 511) >> 6) : 0;
    um &= (kt_hi >= 31) ? 0xffffffffu : ((2u << kt_hi) - 1u);
    const LAS float* bh = bias + hh * 196 + 64;
    f32x4 o[8];
#pragma unroll
    for (int i = 0; i < 8; ++i) o[i] = (f32x4){0.f, 0.f, 0.f, 0.f};
    float m = -1e30f, l = 0.f;
    auto advance = [&](int md, int k, int& md2, int& k2) -> bool {
        md2 = md; k2 = k + 1;
        if (md == 1) {
            const unsigned rem = (k >= 31) ? 0u : (um & ~((2u << k) - 1u));
            if (rem) k2 = __builtin_ctz(rem); else { md2 = 2; k2 = kt_lo_w; }
            return false;
        }
        return k2 > kt_hi;
    };
    int mode = 1, kt = 0, mode2, kt2, cur = 0;
    r2l<256, 64, 272>(rk, lds + N_K, tid);
    r2l<128, 128, 144>(rv, lds + N_V, tid);
    bool done2 = advance(mode, kt, mode2, kt2);
    if (!done2) {
        g2r<256, 64>(rk, (mode2 == 1 ? ksb : kwb) + (size_t)kt2 * 64 * 128, 128, tid);
        g2r<128, 128>(rv, (mode2 == 1 ? vsb : vwb) + kt2 * 64, 2048, tid);
    }
    __syncthreads();
    for (;;) {
        LAS unsigned char* sb = lds + cur * N_STG;
        int mode3 = 0, kt3 = 0; bool done3 = true;
        if (!done2) {
            r2l<256, 64, 272>(rk, lds + (cur ^ 1) * N_STG + N_K, tid);
            r2l<128, 128, 144>(rv, lds + (cur ^ 1) * N_STG + N_V, tid);
            done3 = advance(mode2, kt2, mode3, kt3);
            if (!done3) {
                g2r<256, 64>(rk, (mode3 == 1 ? ksb : kwb) + (size_t)kt3 * 64 * 128, 128, tid);
                g2r<128, 128>(rv, (mode3 == 1 ? vsb : vwb) + kt3 * 64, 2048, tid);
            }
        }
        f32x4 s[4];
        qk_tile<128>(sb + N_K, fr, fq, qf, s);
        const bool selok = mode == 2 || ((mysel >> kt) & 1u) != 0u;
        const bool near = kt * 64 + 191 > t0;
        const bool far = !near && (mode == 1 || (t0 + 31 - kt * 64 < 512));
        float alpha;
        if (far) {
            const float b128 = bh[128];
#pragma unroll
            for (int nt = 0; nt < 4; ++nt)
#pragma unroll
                for (int j = 0; j < 4; ++j) s[nt][j] = selok ? fmaf(s[nt][j], 0.08838834764831845f * LOG2E_, b128) : -1e30f;
            alpha = softmax_step<false>(s, m, l, lane);
        } else if (near) {
            const int r0 = t - kt * 64 - fq * 4;
#pragma unroll
            for (int nt = 0; nt < 4; ++nt)
#pragma unroll
                for (int j = 0; j < 4; ++j) {
                    int rel = r0 - (nt * 16 + j); rel = rel > 128 ? 128 : rel;
                    const float v = fmaf(s[nt][j], 0.08838834764831845f * LOG2E_, bh[rel]);
                    s[nt][j] = selok ? v : -1e30f;
                }
            alpha = softmax_step<false>(s, m, l, lane);
        } else {
            const float b128 = bh[128];
            const int r0 = t - kt * 64 - fq * 4;
#pragma unroll
            for (int nt = 0; nt < 4; ++nt)
#pragma unroll
                for (int j = 0; j < 4; ++j) s[nt][j] = (r0 - (nt * 16 + j) < 512) ? fmaf(s[nt][j], 0.08838834764831845f * LOG2E_, b128) : -1e30f;
            alpha = softmax_step<true>(s, m, l, lane);
        }
#pragma unroll
        for (int i = 0; i < 8; ++i) o[i] *= alpha;
        pv_tile<128, 144>(sb + N_V, fr, fq, s, o);
        if (done2 || mode2 != mode) {
            l += shx(l, lane, 16); l += shx(l, lane, 32);
            const float sc = (mode == 1 ? g1 : g2) / fmaxf(l, 1e-30f);
#pragma unroll
            for (int i = 0; i < 8; ++i) { y[i] += o[i] * sc; o[i] = (f32x4){0.f, 0.f, 0.f, 0.f}; }
            m = -1e30f; l = 0.f;
        }
        if (done2) break;
        __syncthreads();
        cur ^= 1; mode = mode2; kt = kt2; mode2 = mode3; kt2 = kt3; done2 = done3;
    }
    bf16_t* yo = (bf16_t*)(P.ws + O_YA) + row * 1024 + H * 128 + fq * 4;
#pragma unroll
    for (int i = 0; i < 8; ++i) st4(yo + i * 16, y[i]);
}

DI void qk_tile2(const LAS unsigned char* Ks, int fr, int fq, const bf16x8 (&q0)[4], const bf16x8 (&q1)[4], f32x4 (&s0)[4], f32x4 (&s1)[4]) {
    const LAS unsigned char* base = Ks + fr * 272 + fq * 16;
#pragma unroll
    for (int nt = 0; nt < 4; ++nt) {
        bf16x8 kf[4];
#pragma unroll
        for (int kk = 0; kk < 4; ++kk) kf[kk] = *(const LAS bf16x8*)(base + nt * 16 * 272 + kk * 64);
        f32x4 a = (f32x4){0.f, 0.f, 0.f, 0.f}, b = (f32x4){0.f, 0.f, 0.f, 0.f};
#pragma unroll
        for (int kk = 0; kk < 4; ++kk) { a = __builtin_amdgcn_mfma_f32_16x16x32_bf16(kf[kk], q0[kk], a, 0, 0, 0); b = __builtin_amdgcn_mfma_f32_16x16x32_bf16(kf[kk], q1[kk], b, 0, 0, 0); }
        s0[nt] = a; s1[nt] = b;
    }
}
template <int VSTR>
DI void pv_tile2(const LAS unsigned char* Vt, int fr, int fq, const f32x4 (&p0)[4], const f32x4 (&p1)[4], f32x4 (&o0)[8], f32x4 (&o1)[8]) {
    bf16x8 pf0[2], pf1[2];
#pragma unroll
    for (int ks = 0; ks < 2; ++ks) {
        u32x4 a, b;
        a[0] = cvt_pk_bf16(p0[2 * ks][0], p0[2 * ks][1]); a[1] = cvt_pk_bf16(p0[2 * ks][2], p0[2 * ks][3]); a[2] = cvt_pk_bf16(p0[2 * ks + 1][0], p0[2 * ks + 1][1]); a[3] = cvt_pk_bf16(p0[2 * ks + 1][2], p0[2 * ks + 1][3]);
        b[0] = cvt_pk_bf16(p1[2 * ks][0], p1[2 * ks][1]); b[1] = cvt_pk_bf16(p1[2 * ks][2], p1[2 * ks][3]); b[2] = cvt_pk_bf16(p1[2 * ks + 1][0], p1[2 * ks + 1][1]); b[3] = cvt_pk_bf16(p1[2 * ks + 1][2], p1[2 * ks + 1][3]);
        pf0[ks] = __builtin_bit_cast(bf16x8, a); pf1[ks] = __builtin_bit_cast(bf16x8, b);
    }
    const LAS unsigned char* base = Vt + fr * VSTR + fq * 8;
#pragma unroll
    for (int g = 0; g < 4; ++g) {
        bf16x4 lo[2][2], hi[2][2];
#pragma unroll
        for (int d2 = 0; d2 < 2; ++d2)
#pragma unroll
            for (int ks = 0; ks < 2; ++ks) { const LAS unsigned char* q = base + (g * 2 + d2) * 16 * VSTR + ks * 64; lo[d2][ks] = *(const LAS bf16x4*)q; hi[d2][ks] = *(const LAS bf16x4*)(q + 32); }
#pragma unroll
        for (int ks = 0; ks < 2; ++ks)
#pragma unroll
            for (int d2 = 0; d2 < 2; ++d2) {
                const bf16x8 vf = __builtin_shufflevector(lo[d2][ks], hi[d2][ks], 0, 1, 2, 3, 4, 5, 6, 7);
                o0[g * 2 + d2] = __builtin_amdgcn_mfma_f32_16x16x32_bf16(vf, pf0[ks], o0[g * 2 + d2], 0, 0, 0);
                o1[g * 2 + d2] = __builtin_amdgcn_mfma_f32_16x16x32_bf16(vf, pf1[ks], o1[g * 2 + d2], 0, 0, 0);
            }
    }
}
DI f32x4 unpk4(u32x2 w) { f32x4 r; r[0] = __uint_as_float(w.x << 16); r[1] = __uint_as_float(w.x & 0xffff0000u); r[2] = __uint_as_float(w.y << 16); r[3] = __uint_as_float(w.y & 0xffff0000u); return r; }
DI u32x2 pk4(f32x4 v) { u32x2 w; w.x = cvt_pk_bf16(v[0], v[1]); w.y = cvt_pk_bf16(v[2], v[3]); return w; }
DI void nsa_item2(KP& P, LAS unsigned char* lds, int bl, int g, int tt, int wv) {
    const int tid = opq_v(TIDX), wid = tid >> 6, lane = tid & 63, fr = lane & 15, fq = lane >> 4;
    const int hp = wid & 1, ts = wid >> 1, t0 = tt * 64, t = t0 + ts * 16 + fr, bgi = bl * 2 + g, H0 = g * 4 + hp * 2;
    const size_t row = (size_t)bl * 2048 + t;
    constexpr int KST = 17408, VB = 34816, VST = 18432, A2_BIAS = VB + 3 * VST, A2_PART = A2_BIAS + 3136, A2_EDGE = A2_PART + 16384, A2_SELM = A2_EDGE + 16384;
    static_assert(A2_SELM + 256 <= LDS_PHASE, "nsa2 LDS");
    LAS float* bias = (LAS float*)(lds + A2_BIAS);
    LAS float* part = (LAS float*)(lds + A2_PART);
    LAS float* edge = (LAS float*)(lds + A2_EDGE);
    LAS unsigned* selm = (LAS unsigned*)(lds + A2_SELM);
    const bf16_t* ksb = (const bf16_t*)(P.ws + O_KS) + (size_t)bgi * 2048 * 128;
    const bf16_t* kwb = (const bf16_t*)(P.ws + O_KW) + (size_t)bgi * 2048 * 128;
    const bf16_t* vsb = (const bf16_t*)(P.ws + O_VST) + (size_t)bgi * 128 * 2048;
    const bf16_t* vwb = (const bf16_t*)(P.ws + O_VWT) + (size_t)bgi * 128 * 2048;
    u32x4 rk[2], rv[2];
    __syncthreads();
    {
        u32x4 ck[4], cv[4];
        g2r<256, 128>(ck, (const bf16_t*)(P.ws + O_KCMP) + (size_t)bgi * 128 * 128, 128, tid);
        g2r<256, 128>(cv, (const bf16_t*)(P.ws + O_VCMT) + (size_t)bgi * 128 * 128, 128, tid);
        for (int i = tid; i < 4 * 193; i += NT) { const int h4 = i / 193, r = i % 193 - 64; bias[h4 * 196 + r + 64] = r < 0 ? -1e30f : P.in[9][t5_bucket(r) * 8 + g * 4 + h4] * 1.4426950408889634f; }
        r2l<256, 128, 272>(ck, lds, tid);
        r2l<256, 128, 272>(cv, lds + VB, tid);
    }
    bf16x8 q0[4], q1[4];
    { const bf16_t* qp = (const bf16_t*)(P.ws + O_QA) + row * 1024 + H0 * 128 + fq * 8;
#pragma unroll
      for (int kk = 0; kk < 4; ++kk) { q0[kk] = *(const bf16x8*)(qp + kk * 32); q1[kk] = *(const bf16x8*)(qp + 128 + kk * 32); } }
    const float* gt = (const float*)(P.ws + O_GATE) + row * 24 + H0;
    const float g00 = gt[0], g01 = gt[1], g10 = gt[8], g11 = gt[9], g20 = gt[16], g21 = gt[17];
    const LAS float* bh0 = bias + (hp * 2) * 196 + 64;
    const LAS float* bh1 = bh0 + 196;
    bf16_t* yo = (bf16_t*)(P.ws + O_YA) + row * 1024 + H0 * 128 + fq * 4;
    __syncthreads();
#pragma unroll
    for (int hd = 0; hd < 2; ++hd) {
        f32x4 sc[2][4];
        qk_tile<128>(lds, fr, fq, hd ? q1 : q0, sc[0]);
        qk_tile<128>(lds + 64 * 272, fr, fq, hd ? q1 : q0, sc[1]);
        const LAS float* bh = hd ? bh1 : bh0;
        float mx = -1e30f;
#pragma unroll
        for (int kt = 0; kt < 2; ++kt)
#pragma unroll
            for (int nt = 0; nt < 4; ++nt)
#pragma unroll
                for (int j = 0; j < 4; ++j) {
                    const int n = kt * 64 + nt * 16 + fq * 4 + j; int rel = t - 16 * n - 31;
                    rel = rel < -64 ? -64 : (rel > 128 ? 128 : rel);
                    const float v = fmaf(sc[kt][nt][j], 0.08838834764831845f * LOG2E_, bh[rel]);
                    sc[kt][nt][j] = v; mx = fmaxf(mx, v);
                }
        mx = fmaxf(mx, shx(mx, lane, 16)); mx = fmaxf(mx, shx(mx, lane, 32));
        float ls = 0.f;
#pragma unroll
        for (int kt = 0; kt < 2; ++kt)
#pragma unroll
            for (int nt = 0; nt < 4; ++nt)
#pragma unroll
                for (int j = 0; j < 4; ++j) { const float pv = sc[kt][nt][j] > -1e29f ? __builtin_amdgcn_exp2f(sc[kt][nt][j] - mx) : 0.f; sc[kt][nt][j] = pv; ls += pv; }
        ls += shx(ls, lane, 16); ls += shx(ls, lane, 32);
        const float inv = 1.0f / fmaxf(ls, 1e-30f);
#pragma unroll
        for (int kt = 0; kt < 2; ++kt)
#pragma unroll
            for (int nt = 0; nt < 4; ++nt) {
                sc[kt][nt] *= inv;
                const int jidx = kt * 16 + nt * 4 + fq, oo = (hp * 64 + ts * 16 + fr) * 32 + jidx;
                const float ps = (sc[kt][nt][0] + sc[kt][nt][1]) + (sc[kt][nt][2] + sc[kt][nt][3]);
                if (hd == 0) { part[oo] = ps; edge[oo] = sc[kt][nt][3]; } else { part[oo] += ps; edge[oo] += sc[kt][nt][3]; }
            }
        f32x4 oc[8];
#pragma unroll
        for (int i = 0; i < 8; ++i) oc[i] = (f32x4){0.f, 0.f, 0.f, 0.f};
        pv_tile<128, 272>(lds + VB, fr, fq, sc[0], oc);
        pv_tile<128, 272>(lds + VB + 128, fr, fq, sc[1], oc);
        const float gc = hd ? g01 : g00;
#pragma unroll
        for (int i = 0; i < 8; ++i) st4(yo + hd * 128 + i * 16, oc[i] * gc);
    }
    g2r<256, 64>(rk, ksb, 128, tid);
    g2r<128, 128>(rv, vsb, 2048, tid);
    __syncthreads();
#pragma unroll
    for (int pass = 0; pass < 4; ++pass) {
        const int tok = pass * 16 + wid * 2 + (lane >> 5), j = lane & 31;
        float v = 0.f;
#pragma unroll
        for (int h2 = 0; h2 < 2; ++h2) { const int oo = (h2 * 64 + tok) * 32 + j; v += part[oo] + (j > 0 ? edge[oo - 1] : 0.f); }
        const int cur = tt;
        if (j == 0 || (cur - j >= 0 && cur - j < 2)) v = 1e4f;
        if (j > cur) v = -1.0f;
        int rank = 0;
#pragma unroll
        for (int i = 0; i < 32; ++i) { const float vi = shl(v, (lane & 32) + i); rank += (vi > v || (vi == v && i < j)) ? 1 : 0; }
        const unsigned long long bal = __ballot(rank < 16);
        if (j == 0) selm[tok] = (unsigned)((lane & 32) ? (bal >> 32) : (bal & 0xffffffffull));
    }
    __syncthreads();
    unsigned um = selm[lane];
#pragma unroll
    for (int oo = 32; oo > 0; oo >>= 1) um |= (unsigned)__builtin_amdgcn_ds_bpermute((lane ^ oo) << 2, (int)um);
    um = (unsigned)__builtin_amdgcn_readfirstlane((int)um);
    const unsigned mysel = selm[ts * 16 + fr];
    const int kt_hi = tt, kt_lo_w = (t0 - 511) > 0 ? ((t0 - 511) >> 6) : 0;
    um &= (kt_hi >= 31) ? 0xffffffffu : ((2u << kt_hi) - 1u);
    f32x4 o0[8], o1[8];
#pragma unroll
    for (int i = 0; i < 8; ++i) { o0[i] = (f32x4){0.f, 0.f, 0.f, 0.f}; o1[i] = (f32x4){0.f, 0.f, 0.f, 0.f}; }
    float m0 = -1e30f, l0 = 0.f, m1 = -1e30f, l1 = 0.f;
    auto advance = [&](int md, int k, int& md2, int& k2) -> bool {
        md2 = md; k2 = k + 1;
        if (md == 1) {
            const unsigned rem = (k >= 31) ? 0u : (um & ~((2u << k) - 1u));
            if (rem) k2 = __builtin_ctz(rem); else { md2 = 2; k2 = kt_lo_w; }
            return false;
        }
        return k2 > kt_hi;
    };
    const bool grpB = wid >= 4;
    int mode = 1, kt = 0, mode2, kt2, step = 0, pmode = 1; bool plast = false;
    f32x4 s0[4], s1[4];
    r2l<256, 64, 272>(rk, lds, tid);
    r2l<128, 128, 144>(rv, lds + VB, tid);
    bool done2 = advance(mode, kt, mode2, kt2);
    if (!done2) { g2r<256, 64>(rk, (mode2 == 1 ? ksb : kwb) + (size_t)kt2 * 64 * 128, 128, tid); g2r<128, 128>(rv, (mode2 == 1 ? vsb : vwb) + kt2 * 64, 2048, tid); }
    __syncthreads();
    auto finalize = [&](int md) {
        l0 += shx(l0, lane, 16); l0 += shx(l0, lane, 32); l1 += shx(l1, lane, 16); l1 += shx(l1, lane, 32);
        const float c0 = (md == 1 ? g10 : g20) / fmaxf(l0, 1e-30f), c1 = (md == 1 ? g11 : g21) / fmaxf(l1, 1e-30f);
        asm volatile("s_waitcnt vmcnt(0)" ::: "memory");
#pragma unroll
        for (int i = 0; i < 8; ++i) {
            const u32x2 w0 = *(const u32x2*)(yo + i * 16), w1 = *(const u32x2*)(yo + 128 + i * 16);
            st4(yo + i * 16, unpk4(w0) + o0[i] * c0); st4(yo + 128 + i * 16, unpk4(w1) + o1[i] * c1);
            o0[i] = (f32x4){0.f, 0.f, 0.f, 0.f}; o1[i] = (f32x4){0.f, 0.f, 0.f, 0.f};
        }
        m0 = -1e30f; l0 = 0.f; m1 = -1e30f; l1 = 0.f;
    };
    for (;;) {
        const int ks = step & 1, vs = step % 3;
        int mode3 = 0, kt3 = 0; bool done3 = true;
        if (!done2) {
            r2l<256, 64, 272>(rk, lds + (ks ^ 1) * KST, tid);
            r2l<128, 128, 144>(rv, lds + VB + ((step + 1) % 3) * VST, tid);
            done3 = advance(mode2, kt2, mode3, kt3);
            if (!done3) { g2r<256, 64>(rk, (mode3 == 1 ? ksb : kwb) + (size_t)kt3 * 64 * 128, 128, tid); g2r<128, 128>(rv, (mode3 == 1 ? vsb : vwb) + kt3 * 64, 2048, tid); }
        }
        if (grpB && step > 0) {
            pv_tile2<144>(lds + VB + ((step + 2) % 3) * VST, fr, fq, s0, s1, o0, o1);
            if (plast) finalize(pmode);
        }
        qk_tile2(lds + ks * KST, fr, fq, q0, q1, s0, s1);
        const bool selok = mode == 2 || ((mysel >> kt) & 1u) != 0u;
        const bool near = kt * 64 + 191 > t0;
        const bool far = !near && (mode == 1 || (t0 + 63 - kt * 64 < 512));
        float al0, al1;
        if (far) {
            const float b0 = selok ? bh0[128] : -1e30f, b1 = selok ? bh1[128] : -1e30f;
#pragma unroll
            for (int nt = 0; nt < 4; ++nt) { s0[nt] = s0[nt] * (0.08838834764831845f * LOG2E_) + b0; s1[nt] = s1[nt] * (0.08838834764831845f * LOG2E_) + b1; }
            al0 = softmax_step<false>(s0, m0, l0, lane); al1 = softmax_step<false>(s1, m1, l1, lane);
        } else if (near) {
            const int r0 = t - kt * 64 - fq * 4;
#pragma unroll
            for (int nt = 0; nt < 4; ++nt)
#pragma unroll
                for (int j = 0; j < 4; ++j) {
                    int rel = r0 - (nt * 16 + j); rel = rel > 128 ? 128 : rel;
                    const float v0 = fmaf(s0[nt][j], 0.08838834764831845f * LOG2E_, bh0[rel]), v1 = fmaf(s1[nt][j], 0.08838834764831845f * LOG2E_, bh1[rel]);
                    s0[nt][j] = selok ? v0 : -1e30f; s1[nt][j] = selok ? v1 : -1e30f;
                }
            al0 = softmax_step<false>(s0, m0, l0, lane); al1 = softmax_step<false>(s1, m1, l1, lane);
        } else {
            const float b0 = bh0[128], b1 = bh1[128];
            const int r0 = t - kt * 64 - fq * 4;
#pragma unroll
            for (int nt = 0; nt < 4; ++nt)
#pragma unroll
                for (int j = 0; j < 4; ++j) {
                    const bool in = r0 - (nt * 16 + j) < 512;
                    s0[nt][j] = in ? fmaf(s0[nt][j], 0.08838834764831845f * LOG2E_, b0) : -1e30f; s1[nt][j] = in ? fmaf(s1[nt][j], 0.08838834764831845f * LOG2E_, b1) : -1e30f;
                }
            al0 = softmax_step<true>(s0, m0, l0, lane); al1 = softmax_step<true>(s1, m1, l1, lane);
        }
        if (__builtin_amdgcn_ballot_w64(al0 != 1.0f || al1 != 1.0f) != 0ull) {
#pragma unroll
            for (int i = 0; i < 8; ++i) { o0[i] *= al0; o1[i] *= al1; }
        }
        const bool last = done2 || mode2 != mode;
        if (!grpB) {
            pv_tile2<144>(lds + VB + vs * VST, fr, fq, s0, s1, o0, o1);
            if (last) finalize(mode);
        }
        pmode = mode; plast = last;
        if (done2) break;
        __syncthreads();
        ++step; mode = mode2; kt = kt2; mode2 = mode3; kt2 = kt3; done2 = done3;
    }
    if (grpB) { pv_tile2<144>(lds + VB + (step % 3) * VST, fr, fq, s0, s1, o0, o1); finalize(pmode); }
}

DI void ret_item(KP& P, LAS unsigned char* lds, int bl, int h, int qt, int wv) {
    const int tid = opq_v(TIDX), wid = tid >> 6, lane = tid & 63, fr = lane & 15, fq = lane >> 4;
    const int t0 = qt * 128, t = t0 + wid * 16 + fr;
    const size_t row = (size_t)bl * 2048 + t;
    const bf16_t* kb = (const bf16_t*)(P.ws + O_RK) + (size_t)bl * 2048 * 512 + h * 128;
    const bf16_t* vb = (const bf16_t*)(P.ws + O_RVT) + ((size_t)bl * 1024 + h * 256) * 2048;
    u32x4 rk[2], rv[4];
    g2r<256, 64>(rk, kb, 512, tid);
    g2r<128, 256>(rv, vb, 2048, tid);
    bf16x8 qf[4];
    { const bf16_t* qp = (const bf16_t*)(P.ws + O_RQ) + row * 512 + h * 128 + fq * 8;
#pragma unroll
      for (int kk = 0; kk < 4; ++kk) qf[kk] = *(const bf16x8*)(qp + kk * 32); }
    const float lg = log2f(1.0f - exp2f(-5.0f - (float)h));
    f32x4 bdec[4];
#pragma unroll
    for (int nt = 0; nt < 4; ++nt)
#pragma unroll
        for (int j = 0; j < 4; ++j) bdec[nt][j] = exp2f(-(float)(nt * 16 + fq * 4 + j) * lg);
    f32x4 o[16];
#pragma unroll
    for (int i = 0; i < 16; ++i) o[i] = (f32x4){0.f, 0.f, 0.f, 0.f};
    const int kt_hi = (t0 + 127) >> 6;
    __syncthreads();
    r2l<256, 64, 272>(rk, lds + R_K, tid);
    r2l<128, 256, 144>(rv, lds + R_V, tid);
    if (kt_hi >= 1) { g2r<256, 64>(rk, kb + (size_t)64 * 512, 512, tid); g2r<128, 256>(rv, vb + 64, 2048, tid); }
    __syncthreads();
    for (int kt = 0; kt <= kt_hi; ++kt) {
        LAS unsigned char* sb = lds + (kt & 1) * R_STG;
        if (kt < kt_hi) {
            r2l<256, 64, 272>(rk, lds + ((kt + 1) & 1) * R_STG + R_K, tid);
            r2l<128, 256, 144>(rv, lds + ((kt + 1) & 1) * R_STG + R_V, tid);
            if (kt + 1 < kt_hi) { g2r<256, 64>(rk, kb + (size_t)(kt + 2) * 64 * 512, 512, tid); g2r<128, 256>(rv, vb + (kt + 2) * 64, 2048, tid); }
        }
        if (kt * 64 <= t0 + wid * 16 + 15) {
        f32x4 s[4];
        qk_tile<128>(sb + R_K, fr, fq, qf, s);
        const float at = __builtin_amdgcn_exp2f((float)(t - kt * 64) * lg);
        if (kt * 64 + 63 <= t0) {
#pragma unroll
            for (int nt = 0; nt < 4; ++nt) s[nt] *= bdec[nt] * at;
        } else {
#pragma unroll
            for (int nt = 0; nt < 4; ++nt)
#pragma unroll
                for (int j = 0; j < 4; ++j) {
                    const int rel = t - (kt * 64 + nt * 16 + fq * 4 + j);
                    s[nt][j] = rel >= 0 ? s[nt][j] * (bdec[nt][j] * at) : 0.f;
                }
        }
        pv_tile<256, 144>(sb + R_V, fr, fq, s, o);
        }
        __syncthreads();
    }
    float sm = 0.f;
#pragma unroll
    for (int i = 0; i < 16; ++i) sm += (o[i][0] + o[i][1]) + (o[i][2] + o[i][3]);
    sm += shx(sm, lane, 16); sm += shx(sm, lane, 32);
    const float mu = sm * (1.0f / 256.0f);
    float vs = 0.f;
#pragma unroll
    for (int i = 0; i < 16; ++i)
#pragma unroll
        for (int j = 0; j < 4; ++j) { const float d = o[i][j] - mu; vs += d * d; }
    vs += shx(vs, lane, 16); vs += shx(vs, lane, 32);
    const float rs = rsqrtf(vs * (1.0f / 256.0f) + EPS);
    const bf16_t* rg = (const bf16_t*)(P.ws + O_RG) + row * 1024 + h * 256 + fq * 4;
    bf16_t* yo = (bf16_t*)(P.ws + O_YB) + row * 1024 + h * 256 + fq * 4;
#pragma unroll
    for (int i = 0; i < 16; ++i) {
        const bf16x4 gv = *(const bf16x4*)(rg + i * 16);
        f32x4 v;
#pragma unroll
        for (int j = 0; j < 4; ++j) v[j] = (o[i][j] - mu) * rs * bf2f((unsigned short)gv[j]);
        st4(yo + i * 16, v);
    }
}

DI void mem_item(KP& P, LAS unsigned char* lds, int bl, int hm, int qt, int wv) {
    const int tid = opq_v(TIDX), wid = tid >> 6, lane = tid & 63, fr = lane & 15, fq = lane >> 4;
    const size_t row = (size_t)bl * 2048 + qt * 128 + wid * 16 + fr;
    const bf16_t* kb = (const bf16_t*)(P.ws + O_MK) + (size_t)bl * 256 * 1024 + hm * 256;
    const bf16_t* vb = (const bf16_t*)(P.ws + O_MVT) + ((size_t)bl * 1024 + hm * 256) * 256;
    u32x4 rk[4], rv[4];
    g2r<512, 64>(rk, kb, 1024, tid);
    g2r<128, 256>(rv, vb, 256, tid);
    bf16x8 qf[8];
    { const bf16_t* qp = (const bf16_t*)(P.ws + O_MQ) + row * 1024 + hm * 256 + fq * 8;
#pragma unroll
      for (int kk = 0; kk < 8; ++kk) qf[kk] = *(const bf16x8*)(qp + kk * 32); }
    f32x4 o[16];
#pragma unroll
    for (int i = 0; i < 16; ++i) o[i] = (f32x4){0.f, 0.f, 0.f, 0.f};
    float m = -1e30f, l = 0.f;
    constexpr int M_V = 33792, M_STG = M_V + 36864;
    static_assert(2 * M_STG <= LDS_PHASE, "memory attention LDS");
    __syncthreads();
    r2l<512, 64, 528>(rk, lds, tid);
    r2l<128, 256, 144>(rv, lds + M_V, tid);
    g2r<512, 64>(rk, kb + (size_t)64 * 1024, 1024, tid); g2r<128, 256>(rv, vb + 64, 256, tid);
    __syncthreads();
    for (int kt = 0; kt < 4; ++kt) {
        LAS unsigned char* sb = lds + (kt & 1) * M_STG;
        if (kt < 3) {
            r2l<512, 64, 528>(rk, lds + ((kt + 1) & 1) * M_STG, tid);
            r2l<128, 256, 144>(rv, lds + ((kt + 1) & 1) * M_STG + M_V, tid);
            if (kt < 2) { g2r<512, 64>(rk, kb + (size_t)(kt + 2) * 64 * 1024, 1024, tid); g2r<128, 256>(rv, vb + (kt + 2) * 64, 256, tid); }
        }
        f32x4 s[4];
        qk_tile<256>(sb, fr, fq, qf, s);
#pragma unroll
        for (int nt = 0; nt < 4; ++nt) s[nt] *= 0.0625f * LOG2E_;
        const float alpha = softmax_step<false>(s, m, l, lane);
#pragma unroll
        for (int i = 0; i < 16; ++i) o[i] *= alpha;
        pv_tile<256, 144>(sb + M_V, fr, fq, s, o);
        __syncthreads();
    }
    l += shx(l, lane, 16); l += shx(l, lane, 32);
    const float inv = 1.0f / l;
    bf16_t* yo = (bf16_t*)(P.ws + O_YC) + row * 1024 + hm * 256 + fq * 4;
#pragma unroll
    for (int i = 0; i < 16; ++i) st4(yo + i * 16, o[i] * inv);
}

DI void rms_rows(const float* x, const float* g, bf16_t* out, int nrows, int wv) {
    const int tidq = opq_v(TIDX), lane = tidq & 63, gw = opq_s(blockIdx.x) * 8 + (tidq >> 6), nw = gridDim.x * 8;
    for (int r = gw; r < nrows; r += nw) {
        const float* xr = x + (size_t)r * 2048;
        f32x4 v[8]; float ss = 0.f;
#pragma unroll
        for (int i = 0; i < 4; ++i) {
            v[2 * i] = *(const f32x4*)(xr + i * 512 + lane * 8); v[2 * i + 1] = *(const f32x4*)(xr + i * 512 + lane * 8 + 4);
#pragma unroll
            for (int j = 0; j < 4; ++j) ss += v[2 * i][j] * v[2 * i][j] + v[2 * i + 1][j] * v[2 * i + 1][j];
        }
        ss = wave_sum(ss, lane);
        const float rs = rsqrtf(ss * (1.0f / 2048.0f) + EPS);
#pragma unroll
        for (int i = 0; i < 4; ++i) {
            const f32x4 ga = *(const f32x4*)(g + i * 512 + lane * 8), gb = *(const f32x4*)(g + i * 512 + lane * 8 + 4);
            st4(out + (size_t)r * 2048 + i * 512 + lane * 8, v[2 * i] * rs * ga);
            st4(out + (size_t)r * 2048 + i * 512 + lane * 8 + 4, v[2 * i + 1] * rs * gb);
        }
    }
}
template <int MODE>
DI void resid_rows(const float* xf, const bf16_t* xb, const bf16_t* y, const float* g1, const float* g2, float* outf, bf16_t* outb, bf16_t* h2, int nrows, int wv) {
    const int tidq = opq_v(TIDX), lane = tidq & 63, gw = opq_s(blockIdx.x) * 8 + (tidq >> 6), nw = gridDim.x * 8;
    for (int r = gw; r < nrows; r += 2 * nw) {
        const bool two = r + nw < nrows;
        const int rows[2] = {r, two ? r + nw : r};
        bf16x8 yb[2][4]; f32x4 xv[2][8];
#pragma unroll
        for (int rr = 0; rr < 2; ++rr) {
#pragma unroll
            for (int i = 0; i < 4; ++i) yb[rr][i] = *(const bf16x8*)(y + (size_t)rows[rr] * 2048 + i * 512 + lane * 8);
#pragma unroll
            for (int i = 0; i < 4; ++i) {
                if (MODE == 1) { xv[rr][2 * i] = *(const f32x4*)(xf + (size_t)rows[rr] * 2048 + i * 512 + lane * 8); xv[rr][2 * i + 1] = *(const f32x4*)(xf + (size_t)rows[rr] * 2048 + i * 512 + lane * 8 + 4); }
                else { const bf16x8 b = *(const bf16x8*)(xb + (size_t)rows[rr] * 2048 + i * 512 + lane * 8);
#pragma unroll
                    for (int j = 0; j < 4; ++j) { xv[rr][2 * i][j] = bf2f((unsigned short)b[j]); xv[rr][2 * i + 1][j] = bf2f((unsigned short)b[4 + j]); } }
            }
        }
#pragma unroll
        for (int rr = 0; rr < 2; ++rr) {
            if (rr == 1 && !two) break;
            float yv[32]; float ss = 0.f;
#pragma unroll
            for (int i = 0; i < 4; ++i)
#pragma unroll
                for (int j = 0; j < 8; ++j) { const float f = bf2f((unsigned short)yb[rr][i][j]); yv[i * 8 + j] = f; ss += f * f; }
            ss = wave_sum(ss, lane);
            const float rs = rsqrtf(ss * (1.0f / 2048.0f) + EPS);
            float s2 = 0.f;
#pragma unroll
            for (int i = 0; i < 4; ++i) {
                const int c = i * 512 + lane * 8;
                const f32x4 ga = *(const f32x4*)(g1 + c), gb = *(const f32x4*)(g1 + c + 4);
                f32x4 oa, ob;
#pragma unroll
                for (int j = 0; j < 4; ++j) {
                    oa[j] = xv[rr][2 * i][j] + yv[i * 8 + j] * rs * ga[j]; ob[j] = xv[rr][2 * i + 1][j] + yv[i * 8 + 4 + j] * rs * gb[j];
                    yv[i * 8 + j] = oa[j]; yv[i * 8 + 4 + j] = ob[j]; s2 += oa[j] * oa[j] + ob[j] * ob[j];
                }
                if (MODE == 1) *(u32x4*)(outb + (size_t)rows[rr] * 2048 + c) = pk8(oa, ob);
                else { *(f32x4*)(outf + (size_t)rows[rr] * 2048 + c) = oa; *(f32x4*)(outf + (size_t)rows[rr] * 2048 + c + 4) = ob; }
            }
            if (MODE == 1) {
                s2 = wave_sum(s2, lane);
                const float r2 = rsqrtf(s2 * (1.0f / 2048.0f) + EPS);
#pragma unroll
                for (int i = 0; i < 4; ++i) {
                    const int c = i * 512 + lane * 8;
                    const f32x4 ga = *(const f32x4*)(g2 + c), gb = *(const f32x4*)(g2 + c + 4);
                    f32x4 oa, ob;
#pragma unroll
                    for (int j = 0; j < 4; ++j) { oa[j] = yv[i * 8 + j] * r2 * ga[j]; ob[j] = yv[i * 8 + 4 + j] * r2 * gb[j]; }
                    *(u32x4*)(h2 + (size_t)rows[rr] * 2048 + c) = pk8(oa, ob);
                }
            }
        }
    }
}
DI void conv_act(const bf16_t* u, const float* cw, const float* cb, bf16_t* act, int wv) {
    constexpr int CG = DFF / 8, TG = MC / 16;
    const int total = CG * TG;
    for (int task = opq_s(blockIdx.x) * NT + opq_v(TIDX); task < total; task += gridDim.x * NT) {
        const int cgp = task % CG, tg = task / CG, c = cgp * 8, r0 = tg * 16;
        float w[2][3][8], b[2][8];
#pragma unroll
        for (int hv = 0; hv < 2; ++hv) {
#pragma unroll
            for (int k = 0; k < 3; ++k) {
                const f32x4 a0 = *(const f32x4*)(cw + (size_t)k * UPC + hv * DFF + c), a1 = *(const f32x4*)(cw + (size_t)k * UPC + hv * DFF + c + 4);
#pragma unroll
                for (int j = 0; j < 4; ++j) { w[hv][k][j] = a0[j]; w[hv][k][4 + j] = a1[j]; }
            }
            const f32x4 b0 = *(const f32x4*)(cb + hv * DFF + c), b1 = *(const f32x4*)(cb + hv * DFF + c + 4);
#pragma unroll
            for (int j = 0; j < 4; ++j) { b[hv][j] = b0[j]; b[hv][4 + j] = b1[j]; }
        }
        float p2[2][8], p1[2][8];
        const bool first = (r0 & 2047) == 0;
#pragma unroll
        for (int hv = 0; hv < 2; ++hv) {
            bf16x8 a = (bf16x8){0, 0, 0, 0, 0, 0, 0, 0}, bb = a;
            if (!first) { a = *(const bf16x8*)(u + (size_t)(r0 - 2) * UPC + hv * DFF + c); bb = *(const bf16x8*)(u + (size_t)(r0 - 1) * UPC + hv * DFF + c); }
#pragma unroll
            for (int j = 0; j < 8; ++j) { p2[hv][j] = bf2f((unsigned short)a[j]); p1[hv][j] = bf2f((unsigned short)bb[j]); }
        }
#pragma unroll 4
        for (int i = 0; i < 16; ++i) {
            float cv[2][8];
#pragma unroll
            for (int hv = 0; hv < 2; ++hv) {
                const bf16x8 a = *(const bf16x8*)(u + (size_t)(r0 + i) * UPC + hv * DFF + c);
#pragma unroll
                for (int j = 0; j < 8; ++j) {
                    const float x0 = bf2f((unsigned short)a[j]);
                    cv[hv][j] = b[hv][j] + w[hv][0][j] * p2[hv][j] + w[hv][1][j] * p1[hv][j] + w[hv][2][j] * x0;
                    p2[hv][j] = p1[hv][j]; p1[hv][j] = x0;
                }
            }
            f32x4 o0, o1;
#pragma unroll
            for (int j = 0; j < 8; ++j) {
                const float xg = cv[0][j];
                const float z = 0.7978845608028654f * (xg + 0.044715f * xg * xg * xg);
                const float r = xg * sigmoidf_(2.0f * z) * cv[1][j];
                if (j < 4) o0[j] = r; else o1[j - 4] = r;
            }
            st4(act + (size_t)(r0 + i) * DFF + c, o0); st4(act + (size_t)(r0 + i) * DFF + c + 4, o1);
        }
    }
}

DI int win_rowmap(int n) {
    if (n < 2560) return n;
    if (n < 2584) return 12800 + (n - 2560);
    if (n < 3608) {
        const int x = n - 2584, head = x >> 7, o = x & 127, hf = o >> 6, a = (o >> 4) & 3, f = (o >> 2) & 3, j = o & 3;
        return 2560 + head * 128 + 32 * a + 8 * f + 4 * hf + j;
    }
    return n - 24;
}
struct WJob { const float* src; bf16_t* dst; int K, N, k0, n0, mapw; };
constexpr int WT_IN = 32 * 51, WT_UP = 32 * 44, WT_DN = 88 * 8, WT_SQ = 32 * 8, WT_BR = 16 * 8, WT_C1 = 64, WT_C2 = 4;
constexpr int WT_TOTAL = WT_IN + WT_UP + WT_DN + WT_SQ + 3 * WT_BR + WT_SQ + 2 * WT_C1 + 2 * WT_C2;
DI WJob wjob(KP& P, int t) {
    WJob j; int ntn; j.mapw = 0;
    unsigned char* w = P.ws;
    if (t < WT_IN) { j.src = P.in[2]; j.dst = (bf16_t*)(w + O_WIN); j.K = 2048; j.N = IN_COLS; ntn = 51; j.mapw = 1; }
    else if ((t -= WT_IN) < WT_UP) { j.src = P.in[15]; j.dst = (bf16_t*)(w + O_WUP); j.K = 2048; j.N = UPC; ntn = 44; j.mapw = 2; }
    else if ((t -= WT_UP) < WT_DN) { j.src = P.in[18]; j.dst = (bf16_t*)(w + O_WDN); j.K = DFF; j.N = 2048; ntn = 8; }
    else if ((t -= WT_DN) < WT_SQ) { j.src = P.in[14]; j.dst = (bf16_t*)(w + O_WO); j.K = 2048; j.N = 2048; ntn = 8; }
    else if ((t -= WT_SQ) < WT_BR) { j.src = P.in[11]; j.dst = (bf16_t*)(w + O_WBR); j.K = 1024; j.N = 2048; ntn = 8; }
    else if ((t -= WT_BR) < WT_BR) { j.src = P.in[12]; j.dst = (bf16_t*)(w + O_WBR) + (size_t)2048 * 1024; j.K = 1024; j.N = 2048; ntn = 8; }
    else if ((t -= WT_BR) < WT_BR) { j.src = P.in[13]; j.dst = (bf16_t*)(w + O_WBR) + 2 * (size_t)2048 * 1024; j.K = 1024; j.N = 2048; ntn = 8; }
    else if ((t -= WT_BR) < WT_SQ) { j.src = P.in[10]; j.dst = (bf16_t*)(w + O_WMKV); j.K = 2048; j.N = 2048; ntn = 8; }
    else if ((t -= WT_SQ) < WT_C1) { j.src = P.in[4]; j.dst = (bf16_t*)(w + O_WC1); j.K = 4096; j.N = 256; ntn = 1; }
    else if ((t -= WT_C1) < WT_C1) { j.src = P.in[7]; j.dst = (bf16_t*)(w + O_WC1) + (size_t)256 * 4096; j.K = 4096; j.N = 256; ntn = 1; }
    else if ((t -= WT_C1) < WT_C2) { j.src = P.in[5]; j.dst = (bf16_t*)(w + O_WC2); j.K = 256; j.N = 128; ntn = 1; }
    else { t -= WT_C2; j.src = P.in[8]; j.dst = (bf16_t*)(w + O_WC2) + (size_t)256 * 256; j.K = 256; j.N = 128; ntn = 1; }
    j.k0 = (t / ntn) * 64; j.n0 = (t % ntn) * 256;
    return j;
}
DI void wjob_load(const WJob& j, f32x4 (&v)[8], int wv, int lane) {
    const int n = j.n0 + lane * 4;
#pragma unroll
    for (int i = 0; i < 8; ++i) v[i] = n < j.N ? *(const f32x4*)(j.src + (size_t)(j.k0 + wv + 8 * i) * j.N + n) : (f32x4){0.f, 0.f, 0.f, 0.f};
}
DI void zero_fill(unsigned char* p, size_t bytes, int wv) {
    for (size_t i = ((size_t)blockIdx.x * NT + TIDX) * 16; i < bytes; i += (size_t)gridDim.x * NT * 16) *(u32x4*)(p + i) = (u32x4){0u, 0u, 0u, 0u};
}
DI void phase_weights(KP& P, LAS unsigned char* lds, int wv) {
    LAS float* tile = (LAS float*)lds;
    const int lane = lane_now(), tid = wv * 64 + lane;
    zero_fill(P.ws + O_WIN + (size_t)IN_COLS * 2048 * 2, (size_t)(INP - IN_COLS) * 2048 * 2, wv);
    zero_fill(P.ws + O_WC2, 2 * (size_t)256 * 256 * 2, wv);
    for (int pb = blockIdx.x; pb < 256; pb += gridDim.x) {
        const int kv = pb >> 7, sl = pb & 127, jcol = tid & 255, hf = tid >> 8;
        const float* pe = P.in[kv ? 6 : 3]; const float* w1 = P.in[kv ? 7 : 4];
        float a = 0.f;
#pragma unroll
        for (int i = 0; i < 16; ++i) { const int ii = sl * 32 + hf * 16 + i; a += pe[ii] * w1[(size_t)ii * 256 + jcol]; }
        __syncthreads();
        tile[tid] = a;
        __syncthreads();
        if (tid < 256) ((float*)(P.ws + O_PEB + 4096))[(size_t)pb * 256 + tid] = tile[tid] + tile[tid + 256];
    }
    f32x4 v[8];
    int t = blockIdx.x;
    WJob j = wjob(P, t < WT_TOTAL - 2 * WT_C2 ? t : 0);
    if (t < WT_TOTAL - 2 * WT_C2) wjob_load(j, v, wv, lane);
    for (; t < WT_TOTAL - 2 * WT_C2; t += gridDim.x) {
        __syncthreads();
#pragma unroll
        for (int i = 0; i < 8; ++i) *(LAS f32x4*)(tile + (wv + 8 * i) * 260 + lane * 4) = v[i];
        __syncthreads();
        const WJob c = j;
        const int tn = t + gridDim.x;
        if (tn < WT_TOTAL - 2 * WT_C2) { j = wjob(P, tn); wjob_load(j, v, wv, lane); }
#pragma unroll
        for (int i = 0; i < 4; ++i) {
            const int ci = tid + NT * i, nl = ci & 255, kq = ci >> 8, n = c.n0 + nl;
            if (n < c.N) {
                u32x4 w;
#pragma unroll
                for (int e = 0; e < 4; ++e) w[e] = cvt_pk_bf16(tile[(kq * 8 + 2 * e) * 260 + nl], tile[(kq * 8 + 2 * e + 1) * 260 + nl]);
                int dr = n;
                if (c.mapw == 1) dr = win_rowmap(n);
                else if (c.mapw == 2) { const int hv = n >= DFF ? 1 : 0, chn = n - hv * DFF; dr = 256 * (chn >> 7) + 128 * hv + (chn & 127); }
                *(u32x4*)(c.dst + (size_t)dr * c.K + c.k0 + kq * 8) = w;
            }
        }
    }
    __syncthreads();
}
DI void phase_weights2(KP& P, LAS unsigned char* lds, int wv) {
    LAS float* tile = (LAS float*)lds;
    const int lane = lane_now(), tid = wv * 64 + lane;
    if (blockIdx.x == 0) {
        const int kv = tid >> 8, jcol = tid & 255;
        const float* pp = (const float*)(P.ws + O_PEB + 4096) + (size_t)kv * 128 * 256 + jcol;
        float s = 0.f;
        for (int sl = 0; sl < 128; ++sl) s += pp[(size_t)sl * 256];
        ((float*)(P.ws + O_PEB))[kv * 256 + jcol] = s;
    }
    for (int t = WT_TOTAL - 2 * WT_C2 + blockIdx.x; t < WT_TOTAL; t += gridDim.x) {
        const WJob c = wjob(P, t);
        f32x4 v[8];
        wjob_load(c, v, wv, lane);
        __syncthreads();
#pragma unroll
        for (int i = 0; i < 8; ++i) *(LAS f32x4*)(tile + (wv + 8 * i) * 260 + lane * 4) = v[i];
        __syncthreads();
#pragma unroll
        for (int i = 0; i < 4; ++i) {
            const int ci = tid + NT * i, nl = ci & 255, kq = ci >> 8, n = c.n0 + nl;
            if (n < c.N) {
                u32x4 w;
#pragma unroll
                for (int e = 0; e < 4; ++e) w[e] = cvt_pk_bf16(tile[(kq * 8 + 2 * e) * 260 + nl], tile[(kq * 8 + 2 * e + 1) * 260 + nl]);
                *(u32x4*)(c.dst + (size_t)n * c.K + c.k0 + kq * 8) = w;
            }
        }
    }
    __syncthreads();
}

DI KP* lp(KP* p) { asm volatile("" : "+s"(p)); return p; }
__global__ void __launch_bounds__(NT, 2) fwd_megakernel(Params Parg) {
    extern __shared__ __attribute__((aligned(16))) unsigned char shm[];
    LAS unsigned char* lds = (LAS unsigned char*)shm;
    cg::grid_group grid = cg::this_grid();
    const int wv = __builtin_amdgcn_readfirstlane((int)(threadIdx.x >> 6));
    KP* kp = (KP*)__builtin_amdgcn_kernarg_segment_ptr();
#define P (*lp(kp))
#define WSP (lp(kp)->ws)
    const int G = gridDim.x, bid = blockIdx.x;
    pg8::StaticOrder S;
    LAS unsigned* bst = (LAS unsigned*)(lds + LDS_PHASE);
    if (TIDX == 0) { const unsigned xcc = xcc_id(); bst[0] = xcc; bst[3] = 0u;
        __hip_atomic_fetch_add((unsigned*)(WSP + O_BAR) + 64 * xcc, 1u, __ATOMIC_RELAXED, __HIP_MEMORY_SCOPE_AGENT); }

    phase_weights(P, lds, wv);
    rms_rows(P.in[0], P.in[19], (bf16_t*)(WSP + O_H), MC, wv);
    rms_rows(P.in[1], P.in[21], (bf16_t*)(WSP + O_MEMN), NB * MEML, wv);
    grid.sync();
    if (TIDX == 0) { unsigned nx = 0u; unsigned* w = (unsigned*)(WSP + O_BAR);
      for (int j = 0; j < 16; ++j) nx += __hip_atomic_load(w + 64 * j, __ATOMIC_RELAXED, __HIP_MEMORY_SCOPE_AGENT) != 0u ? 1u : 0u;
      bst[2] = nx; bst[1] = __hip_atomic_load(w + 64 * bst[0], __ATOMIC_RELAXED, __HIP_MEMORY_SCOPE_AGENT); }
    phase_weights2(P, lds, wv);

#pragma nounroll
    for (int ch = 0; ch < NCHUNK; ++ch) {
        const float* xin = P.in[0] + (size_t)ch * MC * DM;
        float* xout = P.out + (size_t)ch * MC * DM;
        { pg8::Gemm g{(const bf16_t*)(WSP + O_H), (const bf16_t*)(WSP + O_WIN), 2048, 2048, MC, INP, 2048};
          S.init(g.M, g.N, G, opq_s(bid)); pg8::gemm_phase(lds, g, S, EpiInProj{WSP}, wv); }
        { pg8::Gemm g{(const bf16_t*)(WSP + O_MEMN), (const bf16_t*)(WSP + O_WMKV), 2048, 2048, NB * MEML, 2048, 2048};
          S.init(g.M, g.N, G, (bid + 64) % G); pg8::gemm_phase(lds, g, S, EpiMemKV{(bf16_t*)(WSP + O_MK), (bf16_t*)(WSP + O_MVT)}, wv); }
        grid_barrier((unsigned*)(WSP + O_BAR), (LAS unsigned*)(lds + LDS_PHASE), wv);
        {
            unsigned* cdone = (unsigned*)(WSP + O_BAR) + 3072 + 64 * (4 + ch);
            unsigned nunits = 0u;
            if (opq_s(bid) < NB * 256 / 256) { pg8::Gemm g{(const bf16_t*)(WSP + O_KC), (const bf16_t*)(WSP + O_WC1), 2048, 4096, NB * 256, 256, 4096};
              S.init(g.M, g.N, G, opq_s(bid));
              pg8::gemm_phase(lds, g, S, EpiC1{(bf16_t*)(WSP + O_H1), (const float*)(WSP + O_PEB)}, wv);
              asm volatile("s_waitcnt vmcnt(0)" ::: "memory"); __syncthreads(); if (TIDX == 0) { __builtin_amdgcn_fence(__ATOMIC_ACQUIRE, "agent"); asm volatile("s_waitcnt vmcnt(0)" ::: "memory"); } __syncthreads();
              pg8::Gemm g2{(const bf16_t*)(WSP + O_H1), (const bf16_t*)(WSP + O_WC2), 256, 256, NB * 256, 256, 256};
              pg8::gemm_phase(lds, g2, S, EpiC2<0>{(bf16_t*)(WSP + O_KCMP)}, wv); }
            if ((opq_s(bid) + 128) % G < NB * 256 / 256) { pg8::Gemm g{(const bf16_t*)(WSP + O_VC), (const bf16_t*)(WSP + O_WC1) + (size_t)256 * 4096, 2048, 4096, NB * 256, 256, 4096};
              S.init(g.M, g.N, G, (bid + 128) % G);
              pg8::gemm_phase(lds, g, S, EpiC1{(bf16_t*)(WSP + O_H1) + (size_t)NB * 256 * 256, (const float*)(WSP + O_PEB) + 256}, wv);
              asm volatile("s_waitcnt vmcnt(0)" ::: "memory"); __syncthreads(); if (TIDX == 0) { __builtin_amdgcn_fence(__ATOMIC_ACQUIRE, "agent"); asm volatile("s_waitcnt vmcnt(0)" ::: "memory"); } __syncthreads();
              pg8::Gemm g2{(const bf16_t*)(WSP + O_H1) + (size_t)NB * 256 * 256, (const bf16_t*)(WSP + O_WC2) + (size_t)256 * 256, 256, 256, NB * 256, 256, 256};
              pg8::gemm_phase(lds, g2, S, EpiC2<1>{(bf16_t*)(WSP + O_VCMT)}, wv); }
            { const int cu = NB * 256 / 256, ck = opq_s(bid), cv = (ck + 128) % G;
              nunits = (ck < cu ? (unsigned)((cu - 1 - ck) / G + 1) : 0u) + (cv < cu ? (unsigned)((cu - 1 - cv) / G + 1) : 0u); }
            if (nunits != 0u) {
                asm volatile("s_waitcnt vmcnt(0)" ::: "memory");
                __syncthreads();
                if (TIDX == 0) { __builtin_amdgcn_fence(__ATOMIC_RELEASE, "agent"); asm volatile("s_waitcnt vmcnt(0)" ::: "memory");
                    __hip_atomic_fetch_add(cdone, nunits, __ATOMIC_RELAXED, __HIP_MEMORY_SCOPE_AGENT); }
            }
            bool nsa_ready = false;
            for (;;) {
                __syncthreads();
                if (TIDX == 0) bst[4] = __hip_atomic_fetch_add((unsigned*)(WSP + O_BAR) + 3072 + 64 * ch, 1u, __ATOMIC_RELAXED, __HIP_MEMORY_SCOPE_AGENT);
                __syncthreads();
                const int i = (int)bst[4];
                if (i >= 2 * NB * 4 * 16 + NB * 2 * 32) break;
                if (i < NB * 4 * 16) { const int bh = i & 31; ret_item(P, lds, bh >> 2, bh & 3, 15 - (i >> 5), wv); }
                else if (i < 2 * NB * 4 * 16) { const int k = i - NB * 4 * 16, bh = k & 31; mem_item(P, lds, bh >> 2, bh & 3, k >> 5, wv); }
                else {
                    if (!nsa_ready) {
                        if (TIDX == 0) { while (__hip_atomic_load(cdone, __ATOMIC_RELAXED, __HIP_MEMORY_SCOPE_AGENT) < 2u * (NB * 256 / 256)) __builtin_amdgcn_s_sleep(2);
                            __builtin_amdgcn_fence(__ATOMIC_ACQUIRE, "agent"); asm volatile("s_waitcnt vmcnt(0)" ::: "memory"); }
                        __syncthreads();
                        nsa_ready = true;
                    }
                    const int k = i - 2 * NB * 4 * 16, bgi = k & 15;
                    nsa_item2(P, lds, bgi >> 1, bgi & 1, 31 - (k >> 4), wv);
                }
            }
        }
        grid_barrier((unsigned*)(WSP + O_BAR), (LAS unsigned*)(lds + LDS_PHASE), wv);
        { pg8::Gemm g{(const bf16_t*)(WSP + O_YA), (const bf16_t*)(WSP + O_WBR), 1024, 1024, MC, 2048, 1024};
          S.init(g.M, g.N, G, opq_s(bid)); pg8::gemm_phase(lds, g, S, EpiMerge<1>{(bf16_t*)(WSP + O_H), (const bf16_t*)(WSP + O_BG), 0}, wv);
          g.A = (const bf16_t*)(WSP + O_YB); g.Bt = (const bf16_t*)(WSP + O_WBR) + (size_t)2048 * 1024;
          pg8::gemm_phase(lds, g, S, EpiMerge<0>{(bf16_t*)(WSP + O_H), (const bf16_t*)(WSP + O_BG), 2048}, wv);
          g.A = (const bf16_t*)(WSP + O_YC); g.Bt = (const bf16_t*)(WSP + O_WBR) + 2 * (size_t)2048 * 1024;
          pg8::gemm_phase(lds, g, S, EpiMerge<0>{(bf16_t*)(WSP + O_H), (const bf16_t*)(WSP + O_BG), 4096}, wv); }
        grid_barrier((unsigned*)(WSP + O_BAR), (LAS unsigned*)(lds + LDS_PHASE), wv);
        { pg8::Gemm g{(const bf16_t*)(WSP + O_H), (const bf16_t*)(WSP + O_WO), 2048, 2048, MC, 2048, 2048};
          S.init(g.M, g.N, G, opq_s(bid)); pg8::gemm_phase(lds, g, S, EpiStore{(bf16_t*)(WSP + O_MO), 2048}, wv); }
        grid_barrier((unsigned*)(WSP + O_BAR), (LAS unsigned*)(lds + LDS_PHASE), wv);
        resid_rows<1>(xin, nullptr, (const bf16_t*)(WSP + O_MO), P.in[20], P.in[22], nullptr, (bf16_t*)(WSP + O_YA), (bf16_t*)(WSP + O_H), MC, wv);
        grid_barrier((unsigned*)(WSP + O_BAR), (LAS unsigned*)(lds + LDS_PHASE), wv);
        { pg8::Gemm g{(const bf16_t*)(WSP + O_H), (const bf16_t*)(WSP + O_WUP), 2048, 2048, MC, UPC, 2048};
          S.init(g.M, g.N, G, opq_s(bid)); pg8::gemm_phase(lds, g, S, EpiUpConv{(bf16_t*)(WSP + O_ACT), P.in[16], P.in[17], (float*)(WSP + O_HU), (float*)(WSP + O_HF), (LAS float*)(lds + LDS_HALO)}, wv); }
        grid_barrier((unsigned*)(WSP + O_BAR), (LAS unsigned*)(lds + LDS_PHASE), wv);
        conv_fixup((const float*)(WSP + O_HU), (const float*)(WSP + O_HF), P.in[16], P.in[17], (bf16_t*)(WSP + O_ACT), wv);
        grid_barrier((unsigned*)(WSP + O_BAR), (LAS unsigned*)(lds + LDS_PHASE), wv);
        { pg8::Gemm g{(const bf16_t*)(WSP + O_ACT), (const bf16_t*)(WSP + O_WDN), DFF, DFF, MC, 2048, DFF};
          S.init(g.M, g.N, G, opq_s(bid)); pg8::gemm_phase(lds, g, S, EpiStore{(bf16_t*)(WSP + O_MO), 2048}, wv); }
        grid_barrier((unsigned*)(WSP + O_BAR), (LAS unsigned*)(lds + LDS_PHASE), wv);
        resid_rows<0>(nullptr, (const bf16_t*)(WSP + O_YA), (const bf16_t*)(WSP + O_MO), P.in[23], nullptr, xout, nullptr, nullptr, MC, wv);
        if (ch + 1 < NCHUNK) {
            rms_rows(P.in[0] + (size_t)(ch + 1) * MC * DM, P.in[19], (bf16_t*)(WSP + O_H), MC, wv);
            rms_rows(P.in[1] + (size_t)(ch + 1) * NB * MEML * DM, P.in[21], (bf16_t*)(WSP + O_MEMN), NB * MEML, wv);
            grid_barrier((unsigned*)(WSP + O_BAR), (LAS unsigned*)(lds + LDS_PHASE), wv);
        }
    }
}

#undef P
#undef WSP
extern "C" void kernel_launch(void* const* d_in, const int* in_sizes, int n_in, void* d_out, int out_size, void* d_ws, size_t ws_size, hipStream_t stream) {
    static int grid_blocks = 0;
    if (grid_blocks == 0) {
        if (n_in != 24 || ws_size < O_END) { fprintf(stderr, "kernel_launch: unexpected inputs (n_in %d, ws %zu, need %zu)\n", n_in, ws_size, (size_t)O_END); grid_blocks = -1; return; }
        int dev = 0, cus = 0, per_cu = 0;
        hipGetDevice(&dev);
        hipDeviceGetAttribute(&cus, hipDeviceAttributeMultiprocessorCount, dev);
        if (hipFuncSetAttribute((const void*)fwd_megakernel, hipFuncAttributeMaxDynamicSharedMemorySize, LDS_BYTES) != hipSuccess) { fprintf(stderr, "kernel_launch: hipFuncSetAttribute failed\n"); grid_blocks = -1; return; }
        if (hipOccupancyMaxActiveBlocksPerMultiprocessor(&per_cu, (const void*)fwd_megakernel, NT, LDS_BYTES) != hipSuccess || per_cu < 1) { fprintf(stderr, "kernel_launch: occupancy query failed (%d)\n", per_cu); per_cu = 1; (void)hipGetLastError(); }
        grid_blocks = cus * 1;
    }
    if (grid_blocks < 0) return;
    Params p{};
    for (int i = 0; i < 24; ++i) p.in[i] = (const float*)d_in[i];
    p.out = (float*)d_out; p.ws = (unsigned char*)d_ws;
    if (hipMemsetAsync((unsigned char*)d_ws + O_BAR, 0, 16384, stream) != hipSuccess) { fprintf(stderr, "kernel_launch: memset failed\n"); return; }
    void* args[] = {&p};
    hipError_t e = hipLaunchCooperativeKernel((const void*)fwd_megakernel, dim3(grid_blocks), dim3(NT), args, LDS_BYTES, stream);
    if (e != hipSuccess) fprintf(stderr, "cooperative launch failed: %s (grid %d)\n", hipGetErrorString(e), grid_blocks);
}
```

```cpp
#include <hip/hip_runtime.h>
#include <hip/hip_cooperative_groups.h>
#include <cstdio>
namespace cg = cooperative_groups;

#define LAS __attribute__((address_space(3)))
#define DI __device__ __forceinline__
typedef unsigned short bf16_t;
typedef short bf16x8 __attribute__((ext_vector_type(8)));
typedef short bf16x4 __attribute__((ext_vector_type(4)));
typedef float f32x4 __attribute__((ext_vector_type(4)));
typedef unsigned u32x4 __attribute__((ext_vector_type(4)));
typedef unsigned u32x2 __attribute__((ext_vector_type(2)));

constexpr int DM = 2048, SEQ = 2048, BATCH = 16, MEML = 256;
constexpr int NB = 8, NCHUNK = BATCH / NB, MC = NB * SEQ;
constexpr int IN_COLS = 12824, INP = 13056, DFF = 5632, UPC = 2 * DFF;
constexpr float EPS = 1e-6f, LOG2E_ = 1.4426950408889634f;
constexpr int NT = 512;
constexpr int LDS_PHASE = 141312, LDS_HALO = LDS_PHASE + 64, LDS_BYTES = LDS_HALO + 8192;

constexpr size_t O_WIN  = 0;
constexpr size_t O_WUP  = O_WIN  + (size_t)INP * 2048 * 2;
constexpr size_t O_WDN  = O_WUP  + (size_t)UPC * 2048 * 2;
constexpr size_t O_WO   = O_WDN  + (size_t)2048 * DFF * 2;
constexpr size_t O_WBR  = O_WO   + (size_t)2048 * 2048 * 2;
constexpr size_t O_WMKV = O_WBR  + 3 * (size_t)2048 * 1024 * 2;
constexpr size_t O_WC1  = O_WMKV + (size_t)2048 * 2048 * 2;
constexpr size_t O_WC2  = O_WC1  + 2 * (size_t)256 * 4096 * 2;
constexpr size_t O_PEB  = O_WC2  + 2 * (size_t)256 * 256 * 2;
constexpr size_t O_H    = O_PEB  + 4096 + 256 * 256 * 4;
constexpr size_t O_PROJ = O_H    + (size_t)MC * 2048 * 2;
constexpr size_t O_QA   = O_PROJ;
constexpr size_t O_KC   = O_QA   + (size_t)MC * 1024 * 2;
constexpr size_t O_VC   = O_KC   + (size_t)MC * 256 * 2;
constexpr size_t O_KS   = O_VC   + (size_t)MC * 256 * 2;
constexpr size_t O_KW   = O_KS   + (size_t)MC * 256 * 2;
constexpr size_t O_VST  = O_KW   + (size_t)MC * 256 * 2;
constexpr size_t O_VWT  = O_VST  + (size_t)MC * 256 * 2;
constexpr size_t O_GATE = O_VWT  + (size_t)MC * 256 * 2;
constexpr size_t O_RQ   = O_GATE + (size_t)MC * 24 * 4;
constexpr size_t O_RK   = O_RQ   + (size_t)MC * 512 * 2;
constexpr size_t O_RVT  = O_RK   + (size_t)MC * 512 * 2;
constexpr size_t O_RG   = O_RVT  + (size_t)MC * 1024 * 2;
constexpr size_t O_MQ   = O_RG   + (size_t)MC * 1024 * 2;
constexpr size_t O_BG   = O_MQ   + (size_t)MC * 1024 * 2;
constexpr size_t O_PROJ_END = O_BG + (size_t)MC * 6144 * 2;
constexpr size_t O_U    = O_PROJ;
static_assert(O_U + (size_t)MC * UPC * 2 <= O_PROJ_END, "u overlay");
constexpr size_t O_MEMN = O_PROJ_END;
constexpr size_t O_MK   = O_MEMN + (size_t)NB * 256 * 2048 * 2;
constexpr size_t O_MVT  = O_MK   + (size_t)NB * 256 * 1024 * 2;
constexpr size_t O_H1   = O_MVT  + (size_t)NB * 256 * 1024 * 2;
constexpr size_t O_KCMP = O_H1   + 2 * (size_t)NB * 256 * 256 * 2;
constexpr size_t O_VCMT = O_KCMP + (size_t)NB * 2 * 128 * 128 * 2;
constexpr size_t O_YA   = O_VCMT + (size_t)NB * 2 * 128 * 128 * 2;
constexpr size_t O_YB   = O_YA   + (size_t)MC * 1024 * 2;
constexpr size_t O_YC   = O_YB   + (size_t)MC * 1024 * 2;
constexpr size_t O_MO   = O_YC   + (size_t)MC * 1024 * 2;
constexpr size_t O_ACT  = O_MO   + (size_t)MC * 2048 * 2;
constexpr size_t O_BAR  = O_ACT  + (size_t)MC * DFF * 2;
constexpr size_t O_HU   = O_BAR  + 16384;
constexpr size_t O_HF   = O_HU   + (size_t)64 * 2 * UPC * 4;
constexpr size_t O_END  = O_HF   + (size_t)64 * 2 * UPC * 4;
static_assert(O_END <= ((size_t)1 << 30), "workspace");

struct Params { const float* in[24]; float* out; unsigned char* ws; };
typedef const __attribute__((address_space(4))) Params KP;

typedef float f32x2_ __attribute__((ext_vector_type(2)));
typedef __bf16 bf16x2_ __attribute__((ext_vector_type(2)));
DI unsigned cvt_pk_bf16(float lo, float hi) { const f32x2_ v = {lo, hi}; const bf16x2_ b = __builtin_convertvector(v, bf16x2_); return __builtin_bit_cast(unsigned, b); }
DI float bf2f(unsigned short b) { return __uint_as_float(((unsigned)b) << 16); }
DI void st4(bf16_t* p, f32x4 v) { u32x2 w; w.x = cvt_pk_bf16(v[0], v[1]); w.y = cvt_pk_bf16(v[2], v[3]); *(u32x2*)p = w; }
DI float sigmoidf_(float x) { return __builtin_amdgcn_rcpf(1.0f + __builtin_amdgcn_exp2f(-1.4426950408889634f * x)); }
DI int lane_now() { unsigned z = 0u; asm volatile("" : "+v"(z)); return (int)__builtin_amdgcn_mbcnt_hi(~0u, __builtin_amdgcn_mbcnt_lo(~0u, z)); }
#define TIDX (wv * 64 + lane_now())
DI int opq_v(int x) { asm volatile("" : "+v"(x)); return x; }
DI int opq_s(int x) { asm volatile("" : "+s"(x)); return x; }
DI float shx(float v, int lane, int m) { return __int_as_float(__builtin_amdgcn_ds_bpermute((lane ^ m) << 2, __float_as_int(v))); }
DI float shl(float v, int src) { return __int_as_float(__builtin_amdgcn_ds_bpermute(src << 2, __float_as_int(v))); }
DI float wave_sum(float v, int lane) {
#pragma unroll
    for (int o = 32; o > 0; o >>= 1) v += shx(v, lane, o);
    return v; }

DI unsigned xcc_id() { return (unsigned)__builtin_amdgcn_s_getreg((3 << 11) | 20) & 0xFu; }
DI void grid_barrier(unsigned* w, LAS unsigned* st, int wv) {
    asm volatile("s_waitcnt vmcnt(0) lgkmcnt(0)" ::: "memory");
    __syncthreads();
    if (TIDX == 0) {
        const unsigned xcc = st[0], nloc = st[1], nx = st[2], gen = st[3] + 1u;
        st[3] = gen;
        const unsigned old = __hip_atomic_fetch_add(w + 1024 + 64 * xcc, 1u, __ATOMIC_RELAXED, __HIP_MEMORY_SCOPE_AGENT);
        if (old + 1u == gen * nloc) {
            __builtin_amdgcn_fence(__ATOMIC_RELEASE, "agent");
            asm volatile("s_waitcnt vmcnt(0)" ::: "memory");
            __hip_atomic_fetch_add(w + 2048, 1u, __ATOMIC_RELAXED, __HIP_MEMORY_SCOPE_AGENT);
        }
        while (__hip_atomic_load(w + 2048, __ATOMIC_RELAXED, __HIP_MEMORY_SCOPE_AGENT) < gen * nx) __builtin_amdgcn_s_sleep(2);
        __builtin_amdgcn_fence(__ATOMIC_ACQUIRE, "agent");
        asm volatile("s_waitcnt vmcnt(0)" ::: "memory");
    }
    __syncthreads();
}

namespace pg8 {
constexpr int BM = 256, BK = 64, HALF = 128, HTB = HALF * BK * 2, STAGE_BYTES = 8 * HTB, NXCD = 8, WGM = 8;
DI int lds_byte(int r, int c) { const int st = (r >> 4) * 2 + (c >> 5), rr = r & 15, cc = c & 31, ob = rr * 64 + cc * 2; return st * 1024 + (ob ^ (((ob >> 9) & 1) << 5)); }
DI void stage_rc(int b, int& R, int& C) { const int st = b / 1024, sb = b % 1024, swz = sb ^ (((sb >> 9) & 1) << 5); R = (st >> 1) * 16 + swz / 64; C = (st & 1) * 32 + (swz % 64) / 2; }
DI int perm32(int rho) { const int n = rho >> 4, i = rho & 15; return 8 * (i >> 2) + 4 * n + (i & 3); }
struct Unit { int pm, pn; };
struct Gemm { const bf16_t* A; const bf16_t* Bt; int lda, ldb, M, N, K; };
struct StaticOrder {
    int nM, nN, nwg, G, c;
    DI void init(int M, int N, int G_, int c_) { nM = M / BM; nN = N / BM; nwg = nM * nN; G = G_; c = c_; }
    DI bool next(int i, Unit& u) const {
        const long L = (long)i * G + c; if (L >= nwg) return false;
        int wgid = (int)L; { const int q = nwg / NXCD, r = nwg % NXCD, xcd = wgid % NXCD, off = wgid / NXCD; wgid = (xcd < r ? xcd * (q + 1) : r * (q + 1) + (xcd - r) * q) + off; }
        const int nig = WGM * nN, gid = wgid / nig, fm = gid * WGM, gsz = (nM - fm) < WGM ? (nM - fm) : WGM;
        u.pm = fm + ((wgid % nig) % gsz); u.pn = (wgid % nig) / gsz; return true;
    }
};
template <class Epi>
DI void gemm_phase(LAS unsigned char* lds, const Gemm g, const StaticOrder& S, const Epi& E, int wv) {
    const int tid = opq_v(TIDX), wid = __builtin_amdgcn_readfirstlane(tid >> 6), lane = tid & 63, wr = wid >> 2, wc = wid & 3, fr = lane & 15, fq = lane >> 4;
    const int K = g.K, nt = K / BK;
    unsigned voffA[2], voffB[2];
#pragma unroll
    for (int i = 0; i < 2; ++i) { int R, C; stage_rc(tid * 16 + i * 8192, R, C); const int Rb = Epi::PERM ? ((R & ~31) + perm32(R & 31)) : R;
        voffA[i] = (unsigned)(R * g.lda + C) * 2u; voffB[i] = (unsigned)(Rb * g.ldb + C) * 2u; }
    const size_t kstep = (size_t)(BK * 2);
    const size_t hstepA = (size_t)HALF * g.lda * 2, hstepB = (size_t)HALF * g.ldb * 2;
    const size_t tstepA = 2 * hstepA, tstepB = 2 * hstepB;
    const unsigned ldsw = (unsigned)wid * 1024u;
    const int aoff = lds_byte(wr * 64 + fr, fq * 8), boff = lds_byte(wc * 32 + fr, fq * 8);
#define PG8_SA(b, h) (((b) * 2 + (h)) * HTB)
#define PG8_SB(b, h) ((4 + (b) * 2 + (h)) * HTB)
#define PG8_STAGE(bufoff, gbase, voff) do { _Pragma("unroll") for (int _i = 0; _i < 2; ++_i) \
        __builtin_amdgcn_global_load_lds((const unsigned*)((const char*)(gbase) + (voff)[_i]), (LAS unsigned*)(lds + (bufoff) + ldsw + _i * 8192), 16, 0, 0); } while (0)
#define PG8_LDA(dst, b, h) do { _Pragma("unroll") for (int m = 0; m < 4; ++m) _Pragma("unroll") for (int k = 0; k < 2; ++k) dst[m][k] = *(const LAS bf16x8*)(lds + PG8_SA(b, h) + aoff + m * 2048 + k * 1024); } while (0)
#define PG8_LDB(dst, b, h) do { _Pragma("unroll") for (int n = 0; n < 2; ++n) _Pragma("unroll") for (int k = 0; k < 2; ++k) dst[n][k] = *(const LAS bf16x8*)(lds + PG8_SB(b, h) + boff + n * 2048 + k * 1024); } while (0)
#define PG8_MMA(ai, bj, At, Bt) do { __builtin_amdgcn_s_setprio(1); _Pragma("unroll") for (int m = 0; m < 4; ++m) _Pragma("unroll") for (int n = 0; n < 2; ++n) _Pragma("unroll") for (int k = 0; k < 2; ++k) \
        acc[ai][bj][m][n] = __builtin_amdgcn_mfma_f32_16x16x32_bf16(Bt[n][k], At[m][k], acc[ai][bj][m][n], 0, 0, 0); __builtin_amdgcn_s_setprio(0); } while (0)
#define PG8_WAIT_V(n) asm volatile("s_waitcnt vmcnt(" #n ")" ::: "memory")
#define PG8_WAIT_L(n) asm volatile("s_waitcnt lgkmcnt(" #n ")" ::: "memory")
#define PG8_BAR __builtin_amdgcn_s_barrier()
#define PG8_SCHED __builtin_amdgcn_sched_barrier(0)
    Unit cur, nxt; int ui = 0;
    if (!S.next(0, cur)) return;
    f32x4 acc[2][2][4][2];
#pragma unroll
    for (int a = 0; a < 2; ++a)
#pragma unroll
        for (int b = 0; b < 2; ++b)
#pragma unroll
            for (int m = 0; m < 4; ++m)
#pragma unroll
                for (int n = 0; n < 2; ++n) acc[a][b][m][n] = (f32x4){0.f, 0.f, 0.f, 0.f};
    bf16x8 At[4][2], B0[2][2], B1[2][2];
    const char* cA = (const char*)g.A + (size_t)cur.pm * tstepA; const char* cB = (const char*)g.Bt + (size_t)cur.pn * tstepB;
    PG8_STAGE(PG8_SB(0, 0), cB, voffB); PG8_STAGE(PG8_SA(0, 0), cA, voffA); PG8_STAGE(PG8_SB(0, 1), cB + hstepB, voffB); PG8_STAGE(PG8_SA(0, 1), cA + hstepA, voffA);
    if (wr == 1) PG8_BAR;
    PG8_WAIT_V(4); PG8_BAR;
    PG8_STAGE(PG8_SB(1, 0), cB + kstep, voffB); PG8_STAGE(PG8_SA(1, 0), cA + kstep, voffA); PG8_STAGE(PG8_SB(1, 1), cB + hstepB + kstep, voffB);
    PG8_WAIT_V(6); PG8_BAR;
    for (;;) {
        const bool has_next = S.next(ui + 1, nxt);
        const char* nA = has_next ? (const char*)g.A + (size_t)nxt.pm * tstepA : cA; const char* nB = has_next ? (const char*)g.Bt + (size_t)nxt.pn * tstepB : cB;
        for (int t = 0; t < nt; t += 2) {
            const bool last = (t == nt - 2);
            const char* a1 = cA + (size_t)(t + 1) * kstep;
            const char* a2 = last ? nA : cA + (size_t)(t + 2) * kstep; const char* b2 = last ? nB : cB + (size_t)(t + 2) * kstep;
            const char* a3 = a2 + kstep; const char* b3 = b2 + kstep;
            PG8_LDB(B0, 0, 0); PG8_SCHED; PG8_LDA(At, 0, 0); PG8_STAGE(PG8_SA(1, 1), a1 + hstepA, voffA);
            PG8_WAIT_L(8); PG8_BAR; PG8_WAIT_L(0); PG8_MMA(0, 0, At, B0); PG8_BAR; PG8_SCHED;
            PG8_LDB(B1, 0, 1); PG8_STAGE(PG8_SB(0, 0), b2, voffB);
            PG8_BAR; PG8_WAIT_L(0); PG8_MMA(0, 1, At, B1); PG8_BAR;
            PG8_LDA(At, 0, 1); PG8_STAGE(PG8_SA(0, 0), a2, voffA);
            PG8_BAR; PG8_WAIT_L(0); PG8_MMA(1, 0, At, B0); PG8_BAR; PG8_SCHED;
            PG8_STAGE(PG8_SB(0, 1), b2 + hstepB, voffB);
            PG8_WAIT_V(6); PG8_BAR; PG8_MMA(1, 1, At, B1); PG8_BAR;
            PG8_LDB(B0, 1, 0); PG8_SCHED; PG8_LDA(At, 1, 0); PG8_STAGE(PG8_SA(0, 1), a2 + hstepA, voffA);
            PG8_WAIT_L(8); PG8_BAR; PG8_WAIT_L(0); PG8_MMA(0, 0, At, B0); PG8_BAR; PG8_SCHED;
            PG8_LDB(B1, 1, 1); PG8_STAGE(PG8_SB(1, 0), b3, voffB);
            PG8_BAR; PG8_WAIT_L(0); PG8_MMA(0, 1, At, B1); PG8_BAR;
            PG8_LDA(At, 1, 1); PG8_STAGE(PG8_SA(1, 0), a3, voffA);
            PG8_BAR; PG8_WAIT_L(0); PG8_MMA(1, 0, At, B0); PG8_BAR; PG8_SCHED;
            PG8_STAGE(PG8_SB(1, 1), b3 + hstepB, voffB);
            PG8_WAIT_V(6); PG8_BAR; PG8_MMA(1, 1, At, B1); PG8_BAR;
        }
        E(acc, cur, wr, wc, fr, fq);
        if (!has_next) break;
#pragma unroll
        for (int a = 0; a < 2; ++a)
#pragma unroll
            for (int b = 0; b < 2; ++b)
#pragma unroll
                for (int m = 0; m < 4; ++m)
#pragma unroll
                    for (int n = 0; n < 2; ++n) acc[a][b][m][n] = (f32x4){0.f, 0.f, 0.f, 0.f};
        cur = nxt; cA = nA; cB = nB; ++ui;
    }
    PG8_WAIT_V(0);
    if (wr == 0) PG8_BAR;
    PG8_BAR;
#undef PG8_SA
#undef PG8_SB
#undef PG8_STAGE
#undef PG8_LDA
#undef PG8_LDB
#undef PG8_MMA
#undef PG8_WAIT_V
#undef PG8_WAIT_L
#undef PG8_BAR
#undef PG8_SCHED
}
}
using pg8::Unit;
typedef f32x4 Acc[2][2][4][2];

DI u32x4 pk8(f32x4 a, f32x4 b) { u32x4 w; w[0] = cvt_pk_bf16(a[0], a[1]); w[1] = cvt_pk_bf16(a[2], a[3]); w[2] = cvt_pk_bf16(b[0], b[1]); w[3] = cvt_pk_bf16(b[2], b[3]); return w; }
struct EpiStore {
    static constexpr bool PERM = true;
    bf16_t* O; int ldc;
    DI void operator()(const Acc& acc, const Unit& u, int wr, int wc, int fr, int fq) const {
#pragma unroll
        for (int ai = 0; ai < 2; ++ai)
#pragma unroll
            for (int m = 0; m < 4; ++m) {
                const size_t row = (size_t)u.pm * 256 + ai * 128 + wr * 64 + m * 16 + fr;
#pragma unroll
                for (int bj = 0; bj < 2; ++bj) *(u32x4*)(O + row * ldc + u.pn * 256 + bj * 128 + wc * 32 + fq * 8) = pk8(acc[ai][bj][m][0], acc[ai][bj][m][1]);
            }
    }
};
template <int FIRST> struct EpiMerge {
    static constexpr bool PERM = true;
    bf16_t* O; const bf16_t* gate; int goff;
    DI void operator()(const Acc& acc, const Unit& u, int wr, int wc, int fr, int fq) const {
#pragma unroll
        for (int ai = 0; ai < 2; ++ai)
#pragma unroll
            for (int m = 0; m < 4; ++m) {
                const size_t row = (size_t)u.pm * 256 + ai * 128 + wr * 64 + m * 16 + fr;
#pragma unroll
                for (int bj = 0; bj < 2; ++bj) {
                    const int col = u.pn * 256 + bj * 128 + wc * 32 + fq * 8;
                    const bf16x8 gv = *(const bf16x8*)(gate + row * 6144 + goff + col);
                    f32x4 v0 = acc[ai][bj][m][0], v1 = acc[ai][bj][m][1];
#pragma unroll
                    for (int j = 0; j < 4; ++j) { v0[j] *= bf2f((unsigned short)gv[j]); v1[j] *= bf2f((unsigned short)gv[4 + j]); }
                    if (!FIRST) { const bf16x8 ov = *(const bf16x8*)(O + row * 2048 + col);
#pragma unroll
                        for (int j = 0; j < 4; ++j) { v0[j] += bf2f((unsigned short)ov[j]); v1[j] += bf2f((unsigned short)ov[4 + j]); } }
                    *(u32x4*)(O + row * 2048 + col) = pk8(v0, v1);
                }
            }
    }
};
#define ROWLOOP _Pragma("unroll") for (int ai = 0; ai < 2; ++ai) _Pragma("unroll") for (int m = 0; m < 4; ++m)
#define BJLOOP _Pragma("unroll") for (int bj = 0; bj < 2; ++bj)
DI bf16_t bf1(float x) { return (bf16_t)(cvt_pk_bf16(x, 0.f) & 0xffffu); }
DI float dppx1(float x) { return __int_as_float(__builtin_amdgcn_update_dpp(0, __float_as_int(x), 0xB1, 0xf, 0xf, false)); }
DI float dppx2(float x) { return __int_as_float(__builtin_amdgcn_update_dpp(0, __float_as_int(x), 0x4E, 0xf, 0xf, false)); }
DI f32x4 quad_transpose(f32x4 v, int l) {
    const bool o1 = (l & 1) != 0, o2 = (l & 2) != 0;
    const float r0 = dppx1(o1 ? v[0] : v[1]), r1 = dppx1(o1 ? v[2] : v[3]);
    if (o1) { v[0] = r0; v[2] = r1; } else { v[1] = r0; v[3] = r1; }
    const float q0 = dppx2(o2 ? v[0] : v[2]), q1 = dppx2(o2 ? v[1] : v[3]);
    if (o2) { v[0] = q0; v[1] = q1; } else { v[2] = q0; v[3] = q1; }
    return v;
}
struct EpiMemKV {
    static constexpr bool PERM = true;
    bf16_t* mk; bf16_t* mvt;
    DI void operator()(const Acc& acc, const Unit& u, int wr, int wc, int fr, int fq) const {
        const int cb8 = wc * 32 + fq * 8;
        ROWLOOP { const int row = u.pm * 256 + ai * 128 + wr * 64 + m * 16 + fr, bl = row >> 8, mm = row & 255;
            BJLOOP { const int col = u.pn * 256 + bj * 128 + cb8;
                if (u.pn < 4) *(u32x4*)(mk + (size_t)row * 1024 + col) = pk8(acc[ai][bj][m][0], acc[ai][bj][m][1]);
                else {
#pragma unroll
                    for (int n = 0; n < 2; ++n)
#pragma unroll
                        for (int j = 0; j < 4; ++j) mvt[((size_t)bl * 1024 + (col - 1024 + n * 4 + j)) * 256 + mm] = bf1(acc[ai][bj][m][n][j]);
                } } }
    }
};
struct EpiC1 {
    static constexpr bool PERM = true;
    bf16_t* O; const float* peb;
    DI void operator()(const Acc& acc, const Unit& u, int wr, int wc, int fr, int fq) const {
        const int cb8 = wc * 32 + fq * 8;
        ROWLOOP { const size_t row = (size_t)u.pm * 256 + ai * 128 + wr * 64 + m * 16 + fr;
            BJLOOP { const int col = bj * 128 + cb8;
                f32x4 v0 = acc[ai][bj][m][0], v1 = acc[ai][bj][m][1];
#pragma unroll
                for (int j = 0; j < 4; ++j) { const float z0 = v0[j] + peb[col + j], z1 = v1[j] + peb[col + 4 + j]; v0[j] = z0 * sigmoidf_(z0); v1[j] = z1 * sigmoidf_(z1); }
                *(u32x4*)(O + row * 256 + col) = pk8(v0, v1); } }
    }
};
template <int ISV> struct EpiC2 {
    static constexpr bool PERM = true;
    bf16_t* O;
    DI void operator()(const Acc& acc, const Unit& u, int wr, int wc, int fr, int fq) const {
        const int cb8 = wc * 32 + fq * 8;
        ROWLOOP { const int row = u.pm * 256 + ai * 128 + wr * 64 + m * 16 + fr, bg = row >> 7, nn = row & 127;
            f32x4 v0 = acc[ai][0][m][0], v1 = acc[ai][0][m][1];
            if (nn == 127) { v0 = (f32x4){0.f, 0.f, 0.f, 0.f}; v1 = v0; }
            if (!ISV) *(u32x4*)(O + (size_t)row * 128 + cb8) = pk8(v0, v1);
            else {
#pragma unroll
                for (int j = 0; j < 4; ++j) { O[((size_t)bg * 128 + cb8 + j) * 128 + nn] = bf1(v0[j]); O[((size_t)bg * 128 + cb8 + 4 + j) * 128 + nn] = bf1(v1[j]); }
            } }
    }
};
struct EpiInProj {
    static constexpr bool PERM = true;
    unsigned char* ws;
    DI void operator()(const Acc& acc, const Unit& u, int wr, int wc, int fr, int fq) const {
        const int pn = u.pn;
        const int rbase = u.pm * 256 + wr * 64 + fr, cb8 = wc * 32 + fq * 8;
        if (pn < 4) {
            bf16_t* const qa = (bf16_t*)(ws + O_QA);
            ROWLOOP { const int row = rbase + ai * 128 + m * 16;
                BJLOOP *(u32x4*)(qa + (size_t)row * 1024 + pn * 256 + bj * 128 + cb8) = pk8(acc[ai][bj][m][0], acc[ai][bj][m][1]); }
        } else if (pn < 10) {
            const int br = (pn - 4) >> 1, isv = (pn - 4) & 1;
            if (!isv || br == 0) {
                bf16_t* base = (bf16_t*)(ws + (isv ? O_VC : (br == 0 ? O_KC : (br == 1 ? O_KS : O_KW))));
                ROWLOOP { const int row = rbase + ai * 128 + m * 16, bl = row >> 11, s = row & 2047;
                    BJLOOP *(u32x4*)(base + ((size_t)(bl * 2 + bj) * 2048 + s) * 128 + cb8) = pk8(acc[ai][bj][m][0], acc[ai][bj][m][1]); }
            } else {
                bf16_t* base = (bf16_t*)(ws + (br == 1 ? O_VST : O_VWT));
                const int l4 = fr & 3;
                ROWLOOP { const int row = rbase + ai * 128 + m * 16, bl = row >> 11, s4 = (row & 2047) - l4;
                    BJLOOP {
#pragma unroll
                        for (int n = 0; n < 2; ++n) st4(base + ((size_t)(bl * 2 + bj) * 128 + cb8 + n * 4 + l4) * 2048 + s4, quad_transpose(acc[ai][bj][m][n], l4)); } }
            }
        } else if (pn < 14) {
            const int isk = pn >= 12;
            bf16_t* base = (bf16_t*)(ws + (isk ? O_RK : O_RQ));
            const float sc = isk ? 0.08838834764831845f : 1.0f;
            float th[4];
#pragma unroll
            for (int j = 0; j < 4; ++j) th[j] = 1.0f / exp2f(13.287712379549449f * (float)(16 * wc + 4 * fq + j) * (1.0f / 63.0f));
            ROWLOOP { const int row = rbase + ai * 128 + m * 16, s = row & 2047;
                float sn[4], cs[4];
#pragma unroll
                for (int j = 0; j < 4; ++j) {
                    const float a = (float)s * th[j];
                    const float kq = rintf(a * 0.15915494309189535f);
                    float r = fmaf(-kq, 6.28125f, a); r = fmaf(-kq, 1.9353071795864769e-3f, r);
                    sn[j] = __sinf(r); cs[j] = __cosf(r);
                }
                BJLOOP {
                    const int head = ((pn - 10) & 1) * 2 + bj;
                    const f32x4 x1 = acc[ai][bj][m][0], x2 = acc[ai][bj][m][1];
                    f32x4 o1, o2;
#pragma unroll
                    for (int j = 0; j < 4; ++j) { o1[j] = (x1[j] * cs[j] - x2[j] * sn[j]) * sc; o2[j] = (x2[j] * cs[j] + x1[j] * sn[j]) * sc; }
                    *(u32x4*)(base + (size_t)row * 512 + head * 128 + cb8) = pk8(o1, o2);
                } }
        } else if (pn < 18) {
            bf16_t* base = (bf16_t*)(ws + O_RVT);
            const int l4 = fr & 3;
            ROWLOOP { const int row = rbase + ai * 128 + m * 16, bl = row >> 11, s4 = (row & 2047) - l4;
                BJLOOP { const int col = (pn - 14) * 256 + bj * 128 + cb8;
#pragma unroll
                    for (int n = 0; n < 2; ++n) st4(base + ((size_t)bl * 1024 + col + n * 4 + l4) * 2048 + s4, quad_transpose(acc[ai][bj][m][n], l4)); } }
        } else if (pn < 22) {
            bf16_t* base = (bf16_t*)(ws + O_RG);
            ROWLOOP { const int row = rbase + ai * 128 + m * 16;
                BJLOOP { f32x4 v0 = acc[ai][bj][m][0], v1 = acc[ai][bj][m][1];
#pragma unroll
                    for (int j = 0; j < 4; ++j) { v0[j] = v0[j] * sigmoidf_(v0[j]); v1[j] = v1[j] * sigmoidf_(v1[j]); }
                    *(u32x4*)(base + (size_t)row * 1024 + (pn - 18) * 256 + bj * 128 + cb8) = pk8(v0, v1); } }
        } else if (pn < 26) {
            bf16_t* base = (bf16_t*)(ws + O_MQ);
            ROWLOOP { const int row = rbase + ai * 128 + m * 16;
                BJLOOP *(u32x4*)(base + (size_t)row * 1024 + (pn - 22) * 256 + bj * 128 + cb8) = pk8(acc[ai][bj][m][0], acc[ai][bj][m][1]); }
        } else if (pn < 50) {
            bf16_t* base = (bf16_t*)(ws + O_BG);
            ROWLOOP { const int row = rbase + ai * 128 + m * 16;
                BJLOOP { f32x4 v0 = acc[ai][bj][m][0], v1 = acc[ai][bj][m][1];
#pragma unroll
                    for (int j = 0; j < 4; ++j) { v0[j] = sigmoidf_(v0[j]); v1[j] = sigmoidf_(v1[j]); }
                    *(u32x4*)(base + (size_t)row * 6144 + (pn - 26) * 256 + bj * 128 + cb8) = pk8(v0, v1); } }
        } else {
            float* gt = (float*)(ws + O_GATE);
            ROWLOOP { const int row = rbase + ai * 128 + m * 16;
#pragma unroll
                for (int n = 0; n < 2; ++n) { const f32x4 v = acc[ai][0][m][n]; const int col = cb8 + n * 4;
#pragma unroll
                    for (int j = 0; j < 4; ++j) if (col + j < 24) gt[(size_t)row * 24 + col + j] = sigmoidf_(v[j]); } }
        }
    }
};

DI f32x4 bperm4(f32x4 v, int src) { f32x4 r;
#pragma unroll
    for (int j = 0; j < 4; ++j) r[j] = __int_as_float(__builtin_amdgcn_ds_bpermute(src << 2, __float_as_int(v[j]))); return r; }
DI float gelu_tanh(float x) { const float z = 0.7978845608028654f * (x + 0.044715f * x * x * x); return x * sigmoidf_(2.0f * z); }
typedef _Float16 h2_t __attribute__((ext_vector_type(2)));
DI h2_t pkh(float a, float b) { h2_t r; r[0] = (_Float16)a; r[1] = (_Float16)b; return r; }
DI h2_t h2_ror1(h2_t x) { return __builtin_bit_cast(h2_t, __builtin_amdgcn_update_dpp(0, __builtin_bit_cast(int, x), 0x121, 0xf, 0xf, false)); }
DI h2_t h2_ror2(h2_t x) { return __builtin_bit_cast(h2_t, __builtin_amdgcn_update_dpp(0, __builtin_bit_cast(int, x), 0x122, 0xf, 0xf, false)); }
DI h2_t h2_sel(bool c, h2_t a, h2_t b) { return __builtin_bit_cast(h2_t, c ? __builtin_bit_cast(int, a) : __builtin_bit_cast(int, b)); }
struct EpiUpConv {
    static constexpr bool PERM = false;
    bf16_t* act; const float* cw; const float* cb; float* hu; float* hf; LAS float* halo;
    DI void operator()(const Acc& acc, const Unit& u, int wr, int wc, int fr_in, int fq_in) const {
        const int fr = opq_v(fr_in), fq = opq_v(fq_in);
        const int cbase = wc * 32 + fq * 4;
        if (fr >= 14) {
#pragma unroll
            for (int ai = 0; ai < 2; ++ai)
#pragma unroll
                for (int bj = 0; bj < 2; ++bj)
#pragma unroll
                    for (int n = 0; n < 2; ++n) *(LAS f32x4*)(halo + ((2 * ai + wr) * 2 + (fr - 14)) * 256 + bj * 128 + n * 16 + cbase) = acc[ai][bj][3][n];
            if (wr == 1) {
#pragma unroll
                for (int bj = 0; bj < 2; ++bj)
#pragma unroll
                    for (int n = 0; n < 2; ++n) *(f32x4*)(hu + ((size_t)u.pm * 2 + (fr - 14)) * UPC + u.pn * 256 + bj * 128 + n * 16 + cbase) = acc[1][bj][3][n];
            }
        }
        if (wr == 0 && fr < 2) {
#pragma unroll
            for (int bj = 0; bj < 2; ++bj)
#pragma unroll
                for (int n = 0; n < 2; ++n) *(f32x4*)(hf + ((size_t)u.pm * 2 + fr) * UPC + u.pn * 256 + bj * 128 + n * 16 + cbase) = acc[0][bj][0][n];
        }
        asm volatile("s_waitcnt lgkmcnt(0)" ::: "memory");
        __builtin_amdgcn_s_barrier(); asm volatile("" ::: "memory");
        __builtin_amdgcn_s_barrier(); asm volatile("" ::: "memory");
        const bool seqstart = (u.pm & 7) == 0;
        const bool f1 = fr >= 1, f2 = fr >= 2, f0 = fr == 0;
        const h2_t K1 = pkh(-2.3022082f, -2.3022082f), K2 = pkh(-0.10294324f, -0.10294324f), ONE = pkh(1.0f, 1.0f);
#pragma unroll
        for (int n = 0; n < 2; ++n) {
            const int chb = u.pn * 128 + n * 16 + cbase;
            h2_t wg[2][4], wv_[2][4];
#pragma unroll
            for (int jh = 0; jh < 2; ++jh) {
#pragma unroll
                for (int k = 0; k < 3; ++k) { wg[jh][k] = pkh(cw[(size_t)k * UPC + chb + 2 * jh], cw[(size_t)k * UPC + chb + 2 * jh + 1]); wv_[jh][k] = pkh(cw[(size_t)k * UPC + DFF + chb + 2 * jh], cw[(size_t)k * UPC + DFF + chb + 2 * jh + 1]); }
                wg[jh][3] = pkh(cb[chb + 2 * jh], cb[chb + 2 * jh + 1]); wv_[jh][3] = pkh(cb[DFF + chb + 2 * jh], cb[DFF + chb + 2 * jh + 1]);
            }
#pragma unroll
            for (int ai = 0; ai < 2; ++ai) {
                const int q = 2 * ai + wr;
                h2_t p1g[2], p2g[2], p1v[2], p2v[2];
#pragma unroll
                for (int jh = 0; jh < 2; ++jh) { p1g[jh] = pkh(0.f, 0.f); p2g[jh] = p1g[jh]; p1v[jh] = p1g[jh]; p2v[jh] = p1g[jh]; }
                if (q > 0) {
                    const LAS float* hp = halo + ((q - 1) * 2) * 256 + n * 16 + cbase;
                    const f32x4 h2gf = *(const LAS f32x4*)hp, h1gf = *(const LAS f32x4*)(hp + 256), h2vf = *(const LAS f32x4*)(hp + 128), h1vf = *(const LAS f32x4*)(hp + 384);
#pragma unroll
                    for (int jh = 0; jh < 2; ++jh) {
                        const h2_t h2g = pkh(h2gf[2 * jh], h2gf[2 * jh + 1]), h1g = pkh(h1gf[2 * jh], h1gf[2 * jh + 1]), h2v = pkh(h2vf[2 * jh], h2vf[2 * jh + 1]), h1v = pkh(h1vf[2 * jh], h1vf[2 * jh + 1]);
                        p1g[jh] = h1g; p1v[jh] = h1v; p2g[jh] = h2_sel(f0, h2g, h1g); p2v[jh] = h2_sel(f0, h2v, h1v);
                    }
                }
#pragma unroll
                for (int m = 0; m < 4; ++m) {
                    u32x2 w;
#pragma unroll
                    for (int jh = 0; jh < 2; ++jh) {
                        const h2_t xg = pkh(acc[ai][0][m][n][jh * 2], acc[ai][0][m][n][jh * 2 + 1]), xv = pkh(acc[ai][1][m][n][jh * 2], acc[ai][1][m][n][jh * 2 + 1]);
                        const h2_t r1g = h2_ror1(xg), r2g = h2_ror2(xg), r1v = h2_ror1(xv), r2v = h2_ror2(xv);
                        const h2_t a1g = h2_sel(f1, r1g, p1g[jh]), a2g = h2_sel(f2, r2g, p2g[jh]), a1v = h2_sel(f1, r1v, p1v[jh]), a2v = h2_sel(f2, r2v, p2v[jh]);
                        const h2_t yg = wg[jh][3] + wg[jh][0] * a2g + wg[jh][1] * a1g + wg[jh][2] * xg;
                        const h2_t yv = wv_[jh][3] + wv_[jh][0] * a2v + wv_[jh][1] * a1v + wv_[jh][2] * xv;
                        const h2_t arg = yg * (K1 + K2 * (yg * yg));
                        const h2_t d = __builtin_elementwise_exp2(arg) + ONE;
                        h2_t r; r[0] = __builtin_amdgcn_rcph(d[0]); r[1] = __builtin_amdgcn_rcph(d[1]);
                        const h2_t o = (yg * r) * yv;
                        p1g[jh] = r1g; p2g[jh] = r2g; p1v[jh] = r1v; p2v[jh] = r2v;
                        const unsigned pk = cvt_pk_bf16((float)o[0], (float)o[1]);
                        if (jh == 0) w.x = pk; else w.y = pk;
                    }
                    const size_t row = (size_t)u.pm * 256 + ai * 128 + wr * 64 + m * 16 + fr;
                    if (!(q == 0 && m == 0 && fr < 2 && !seqstart)) *(u32x2*)(act + row * DFF + chb) = w;
                }
            }
        }
    }
};
DI void conv_fixup(const float* hu, const float* hf, const float* cw, const float* cb, bf16_t* act, int wv) {
    constexpr int CG4 = DFF / 4;
    for (int task = opq_s(blockIdx.x) * NT + opq_v(TIDX); task < (MC / 256) * CG4; task += gridDim.x * NT) {
        const int cgp = task % CG4, pm = task / CG4;
        if ((pm & 7) == 0) continue;
        const int ch = cgp * 4, colg = 256 * (ch >> 7) + (ch & 127);
        f32x4 y0[2], y1[2];
#pragma unroll
        for (int hv = 0; hv < 2; ++hv) {
            const int col = colg + 128 * hv, cc = ch + hv * DFF;
            const f32x4 a0 = *(const f32x4*)(hu + ((size_t)(pm - 1) * 2 + 0) * UPC + col), a1 = *(const f32x4*)(hu + ((size_t)(pm - 1) * 2 + 1) * UPC + col);
            const f32x4 f0 = *(const f32x4*)(hf + ((size_t)pm * 2 + 0) * UPC + col), f1 = *(const f32x4*)(hf + ((size_t)pm * 2 + 1) * UPC + col);
            const f32x4 w0 = *(const f32x4*)(cw + cc), w1 = *(const f32x4*)(cw + UPC + cc), w2 = *(const f32x4*)(cw + 2 * UPC + cc), b = *(const f32x4*)(cb + cc);
            y0[hv] = b + w0 * a0 + w1 * a1 + w2 * f0;
            y1[hv] = b + w0 * a1 + w1 * f0 + w2 * f1;
        }
        f32x4 o0, o1;
#pragma unroll
        for (int j = 0; j < 4; ++j) { o0[j] = gelu_tanh(y0[0][j]) * y0[1][j]; o1[j] = gelu_tanh(y1[0][j]) * y1[1][j]; }
        st4(act + ((size_t)pm * 256 + 0) * DFF + ch, o0);
        st4(act + ((size_t)pm * 256 + 1) * DFF + ch, o1);
    }
}

constexpr int A_KS = 0, A_VT = 34816;
constexpr int N_STG = 35840, N_K = 0, N_V = 17408;
constexpr int A_BIAS = 2 * N_STG, A_PART = A_BIAS + 3136, A_EDGE = A_PART + 16384, A_SELM = A_EDGE + 16384;
constexpr int R_STG = 54272, R_K = 0, R_V = 17408;
static_assert(2 * R_STG <= LDS_PHASE, "retention LDS");
static_assert(A_SELM + 256 <= LDS_PHASE, "attention LDS");

template <int ROWBYTES, int NROWS>
DI void g2r(u32x4 (&r)[(ROWBYTES / 16) * NROWS / NT], const bf16_t* src, size_t src_stride, int tid) {
    constexpr int CPR = ROWBYTES / 16, N = CPR * NROWS / NT;
    static_assert(CPR * NROWS % NT == 0, "tile chunks");
#pragma unroll
    for (int i = 0; i < N; ++i) { const int c = i * NT + tid, rr = c / CPR, cc = c % CPR; r[i] = *(const u32x4*)((const char*)(src + (size_t)rr * src_stride) + cc * 16); }
}
template <int ROWBYTES, int NROWS, int LSTRIDE>
DI void r2l(const u32x4 (&r)[(ROWBYTES / 16) * NROWS / NT], LAS unsigned char* dst, int tid) {
    constexpr int CPR = ROWBYTES / 16, N = CPR * NROWS / NT;
#pragma unroll
    for (int i = 0; i < N; ++i) { const int c = i * NT + tid, rr = c / CPR, cc = c % CPR; *(LAS u32x4*)(dst + rr * LSTRIDE + cc * 16) = r[i]; }
}
template <int DQK>
DI void qk_tile(const LAS unsigned char* Ks, int fr, int fq, const bf16x8 (&qf)[DQK / 32], f32x4 (&s)[4]) {
    constexpr int KSTR = (DQK + 8) * 2, NK = DQK / 32;
    const LAS unsigned char* base = Ks + fr * KSTR + fq * 16;
#pragma unroll
    for (int nt = 0; nt < 4; ++nt) s[nt] = (f32x4){0.f, 0.f, 0.f, 0.f};
#pragma unroll
    for (int h = 0; h < NK / 4; ++h) {
        bf16x8 kf[4][4];
#pragma unroll
        for (int nt = 0; nt < 4; ++nt)
#pragma unroll
            for (int kk = 0; kk < 4; ++kk) kf[nt][kk] = *(const LAS bf16x8*)(base + nt * 16 * KSTR + (h * 4 + kk) * 64);
#pragma unroll
        for (int kk = 0; kk < 4; ++kk)
#pragma unroll
            for (int nt = 0; nt < 4; ++nt) s[nt] = __builtin_amdgcn_mfma_f32_16x16x32_bf16(kf[nt][kk], qf[h * 4 + kk], s[nt], 0, 0, 0);
    }
}
template <int DV, int VSTR>
DI void pv_tile(const LAS unsigned char* Vt, int fr, int fq, const f32x4 (&p)[4], f32x4 (&o)[DV / 16]) {
    bf16x8 pf[2];
#pragma unroll
    for (int ks = 0; ks < 2; ++ks) {
        u32x4 pw; pw[0] = cvt_pk_bf16(p[2 * ks][0], p[2 * ks][1]); pw[1] = cvt_pk_bf16(p[2 * ks][2], p[2 * ks][3]);
        pw[2] = cvt_pk_bf16(p[2 * ks + 1][0], p[2 * ks + 1][1]); pw[3] = cvt_pk_bf16(p[2 * ks + 1][2], p[2 * ks + 1][3]);
        pf[ks] = __builtin_bit_cast(bf16x8, pw);
    }
    const LAS unsigned char* base = Vt + fr * VSTR + fq * 8;
#pragma unroll
    for (int g = 0; g < DV / 64; ++g) {
        bf16x4 lo[4][2], hi[4][2];
#pragma unroll
        for (int d4 = 0; d4 < 4; ++d4)
#pragma unroll
            for (int ks = 0; ks < 2; ++ks) {
                const LAS unsigned char* q = base + (g * 4 + d4) * 16 * VSTR + ks * 64;
                lo[d4][ks] = *(const LAS bf16x4*)q; hi[d4][ks] = *(const LAS bf16x4*)(q + 32);
            }
#pragma unroll
        for (int ks = 0; ks < 2; ++ks)
#pragma unroll
            for (int d4 = 0; d4 < 4; ++d4) {
                const bf16x8 vf = __builtin_shufflevector(lo[d4][ks], hi[d4][ks], 0, 1, 2, 3, 4, 5, 6, 7);
                o[g * 4 + d4] = __builtin_amdgcn_mfma_f32_16x16x32_bf16(vf, pf[ks], o[g * 4 + d4], 0, 0, 0);
            }
    }
}
template <bool CHECK>
DI float softmax_step(f32x4 (&s)[4], float& m, float& l, int lane) {
    f32x4 mv = s[0];
#pragma unroll
    for (int nt = 1; nt < 4; ++nt)
#pragma unroll
        for (int j = 0; j < 4; ++j) mv[j] = fmaxf(mv[j], s[nt][j]);
    float mt = fmaxf(fmaxf(mv[0], mv[1]), fmaxf(mv[2], mv[3]));
    mt = fmaxf(mt, shx(mt, lane, 16)); mt = fmaxf(mt, shx(mt, lane, 32));
    const float mn = fmaxf(m, mt), alpha = __builtin_amdgcn_exp2f(m - mn);
    f32x4 ps = (f32x4){0.f, 0.f, 0.f, 0.f};
#pragma unroll
    for (int nt = 0; nt < 4; ++nt) {
        const f32x4 d = s[nt] - mn;
        f32x4 pv;
#pragma unroll
        for (int j = 0; j < 4; ++j) { pv[j] = __builtin_amdgcn_exp2f(d[j]); if (CHECK) pv[j] = (s[nt][j] > -1e29f) ? pv[j] : 0.f; }
        s[nt] = pv; ps += pv;
    }
    m = mn; l = l * alpha + ((ps[0] + ps[1]) + (ps[2] + ps[3]));
    return alpha;
}
DI int t5_bucket(int n) {
    if (n < 16) return n;
    int b = 16 + (int)(logf((float)n * (1.0f / 16.0f)) / 2.0794415416798357f * 16.0f);
    return b > 31 ? 31 : b;
}

DI void nsa_item(KP& P, LAS unsigned char* lds, int bl, int g, int tt, int wv) {
    const int tid = opq_v(TIDX), wid = tid >> 6, lane = tid & 63, fr = lane & 15, fq = lane >> 4;
    const int hh = wid & 3, ts = wid >> 2, t0 = tt * 32, t = t0 + ts * 16 + fr, bgi = bl * 2 + g, H = g * 4 + hh;
    const size_t row = (size_t)bl * 2048 + t;
    LAS float* bias = (LAS float*)(lds + A_BIAS);
    LAS float* part = (LAS float*)(lds + A_PART);
    LAS float* edge = (LAS float*)(lds + A_EDGE);
    LAS unsigned* selm = (LAS unsigned*)(lds + A_SELM);
    const bf16_t* ksb = (const bf16_t*)(P.ws + O_KS) + (size_t)bgi * 2048 * 128;
    const bf16_t* kwb = (const bf16_t*)(P.ws + O_KW) + (size_t)bgi * 2048 * 128;
    const bf16_t* vsb = (const bf16_t*)(P.ws + O_VST) + (size_t)bgi * 128 * 2048;
    const bf16_t* vwb = (const bf16_t*)(P.ws + O_VWT) + (size_t)bgi * 128 * 2048;
    u32x4 rk[2], rv[2];
    __syncthreads();
    {
        u32x4 ck[4], cv[4];
        g2r<256, 128>(ck, (const bf16_t*)(P.ws + O_KCMP) + (size_t)bgi * 128 * 128, 128, tid);
        g2r<256, 128>(cv, (const bf16_t*)(P.ws + O_VCMT) + (size_t)bgi * 128 * 128, 128, tid);
        for (int i = tid; i < 4 * 193; i += NT) { const int h4 = i / 193, r = i % 193 - 64; bias[h4 * 196 + r + 64] = r < 0 ? -1e30f : P.in[9][t5_bucket(r) * 8 + g * 4 + h4] * 1.4426950408889634f; }
        r2l<256, 128, 272>(ck, lds, tid);
        r2l<256, 128, 272>(cv, lds + N_STG, tid);
    }
    g2r<256, 64>(rk, ksb, 128, tid);
    g2r<128, 128>(rv, vsb, 2048, tid);
    bf16x8 qf[4];
    { const bf16_t* qp = (const bf16_t*)(P.ws + O_QA) + row * 1024 + H * 128 + fq * 8;
#pragma unroll
      for (int kk = 0; kk < 4; ++kk) qf[kk] = *(const bf16x8*)(qp + kk * 32); }
    const float* gt = (const float*)(P.ws + O_GATE) + row * 24;
    const float g0 = gt[H], g1 = gt[8 + H], g2 = gt[16 + H];
    f32x4 y[8];
#pragma unroll
    for (int i = 0; i < 8; ++i) y[i] = (f32x4){0.f, 0.f, 0.f, 0.f};
    __syncthreads();
    {
        f32x4 sc[2][4];
        qk_tile<128>(lds, fr, fq, qf, sc[0]);
        qk_tile<128>(lds + 64 * 272, fr, fq, qf, sc[1]);
        const LAS float* bh = bias + hh * 196 + 64;
        float mx = -1e30f;
#pragma unroll
        for (int kt = 0; kt < 2; ++kt)
#pragma unroll
            for (int nt = 0; nt < 4; ++nt)
#pragma unroll
                for (int j = 0; j < 4; ++j) {
                    const int n = kt * 64 + nt * 16 + fq * 4 + j, rel = t - 16 * n - 31;
                    const int ri = rel < 0 ? 0 : (rel > 128 ? 128 : rel);
                    const float v = rel >= 0 ? sc[kt][nt][j] * (0.08838834764831845f * 1.4426950408889634f) + bh[ri] : -1e30f;
                    sc[kt][nt][j] = v; mx = fmaxf(mx, v);
                }
        mx = fmaxf(mx, shx(mx, lane, 16)); mx = fmaxf(mx, shx(mx, lane, 32));
        float ls = 0.f;
#pragma unroll
        for (int kt = 0; kt < 2; ++kt)
#pragma unroll
            for (int nt = 0; nt < 4; ++nt)
#pragma unroll
                for (int j = 0; j < 4; ++j) { const float pv = sc[kt][nt][j] > -1e29f ? __builtin_amdgcn_exp2f(sc[kt][nt][j] - mx) : 0.f; sc[kt][nt][j] = pv; ls += pv; }
        ls += shx(ls, lane, 16); ls += shx(ls, lane, 32);
        const float inv = 1.0f / fmaxf(ls, 1e-30f);
#pragma unroll
        for (int kt = 0; kt < 2; ++kt)
#pragma unroll
            for (int nt = 0; nt < 4; ++nt) {
                sc[kt][nt] *= inv;
                const int jidx = kt * 16 + nt * 4 + fq, o = (hh * 32 + ts * 16 + fr) * 32 + jidx;
                part[o] = (sc[kt][nt][0] + sc[kt][nt][1]) + (sc[kt][nt][2] + sc[kt][nt][3]);
                edge[o] = sc[kt][nt][3];
            }
        f32x4 o[8];
#pragma unroll
        for (int i = 0; i < 8; ++i) o[i] = (f32x4){0.f, 0.f, 0.f, 0.f};
        pv_tile<128, 272>(lds + N_STG, fr, fq, sc[0], o);
        pv_tile<128, 272>(lds + N_STG + 128, fr, fq, sc[1], o);
#pragma unroll
        for (int i = 0; i < 8; ++i) y[i] += o[i] * g0;
    }
    __syncthreads();
#pragma unroll
    for (int pass = 0; pass < 2; ++pass) {
        const int tok = pass * 16 + wid * 2 + (lane >> 5), j = lane & 31;
        float v = 0.f;
#pragma unroll
        for (int h4 = 0; h4 < 4; ++h4) { const int o = (h4 * 32 + tok) * 32 + j; v += part[o] + (j > 0 ? edge[o - 1] : 0.f); }
        const int cur = (t0 + tok) >> 6;
        if (j == 0 || (cur - j >= 0 && cur - j < 2)) v = 1e4f;
        if (j > cur) v = -1.0f;
        int rank = 0;
#pragma unroll
        for (int i = 0; i < 32; ++i) { const float vi = shl(v, (lane & 32) + i); rank += (vi > v || (vi == v && i < j)) ? 1 : 0; }
        const unsigned long long bal = __ballot(rank < 16);
        if (j == 0) selm[tok] = (unsigned)((lane & 32) ? (bal >> 32) : (bal & 0xffffffffull));
    }
    __syncthreads();
    unsigned um = selm[lane & 31];
#pragma unroll
    for (int o = 16; o > 0; o >>= 1) um |= (unsigned)__builtin_amdgcn_ds_bpermute((lane ^ o) << 2, (int)um);
    um = (unsigned)__builtin_amdgcn_readfirstlane((int)um);
    const unsigned mysel = selm[ts * 16 + fr];
    const int kt_hi = t0 >> 6, kt_lo_w = (t0 - 511) > 0 ? ((t0 - 511) >> 6) : 0;
    um &= (kt_hi >= 31) ? 0xffffffffu : ((2u << kt_hi) - 1u);
    const LAS float* bh = bias + hh * 196 + 64;
    f32x4 o[8];
#pragma unroll
    for (int i = 0; i < 8; ++i) o[i] = (f32x4){0.f, 0.f, 0.f, 0.f};
    float m = -1e30f, l = 0.f;
    auto advance = [&](int md, int k, int& md2, int& k2) -> bool {
        md2 = md; k2 = k + 1;
        if (md == 1) {
            const unsigned rem = (k >= 31) ? 0u : (um & ~((2u << k) - 1u));
            if (rem) k2 = __builtin_ctz(rem); else { md2 = 2; k2 = kt_lo_w; }
            return false;
        }
        return k2 > kt_hi;
    };
    int mode = 1, kt = 0, mode2, kt2, cur = 0;
    r2l<256, 64, 272>(rk, lds + N_K, tid);
    r2l<128, 128, 144>(rv, lds + N_V, tid);
    bool done2 = advance(mode, kt, mode2, kt2);
    if (!done2) {
        g2r<256, 64>(rk, (mode2 == 1 ? ksb : kwb) + (size_t)kt2 * 64 * 128, 128, tid);
        g2r<128, 128>(rv, (mode2 == 1 ? vsb : vwb) + kt2 * 64, 2048, tid);
    }
    __syncthreads();
    for (;;) {
        LAS unsigned char* sb = lds + cur * N_STG;
        int mode3 = 0, kt3 = 0; bool done3 = true;
        if (!done2) {
            r2l<256, 64, 272>(rk, lds + (cur ^ 1) * N_STG + N_K, tid);
            r2l<128, 128, 144>(rv, lds + (cur ^ 1) * N_STG + N_V, tid);
            done3 = advance(mode2, kt2, mode3, kt3);
            if (!done3) {
                g2r<256, 64>(rk, (mode3 == 1 ? ksb : kwb) + (size_t)kt3 * 64 * 128, 128, tid);
                g2r<128, 128>(rv, (mode3 == 1 ? vsb : vwb) + kt3 * 64, 2048, tid);
            }
        }
        f32x4 s[4];
        qk_tile<128>(sb + N_K, fr, fq, qf, s);
        const bool selok = mode == 2 || ((mysel >> kt) & 1u) != 0u;
        const bool near = kt * 64 + 191 > t0;
        const bool far = !near && (mode == 1 || (t0 + 31 - kt * 64 < 512));
        float alpha;
        if (far) {
            const float b128 = bh[128];
#pragma unroll
            for (int nt = 0; nt < 4; ++nt)
#pragma unroll
                for (int j = 0; j < 4; ++j) s[nt][j] = selok ? fmaf(s[nt][j], 0.08838834764831845f * LOG2E_, b128) : -1e30f;
            alpha = softmax_step<false>(s, m, l, lane);
        } else if (near) {
            const int r0 = t - kt * 64 - fq * 4;
#pragma unroll
            for (int nt = 0; nt < 4; ++nt)
#pragma unroll
                for (int j = 0; j < 4; ++j) {
                    int rel = r0 - (nt * 16 + j); rel = rel > 128 ? 128 : rel;
                    const float v = fmaf(s[nt][j], 0.08838834764831845f * LOG2E_, bh[rel]);
                    s[nt][j] = selok ? v : -1e30f;
                }
            alpha = softmax_step<false>(s, m, l, lane);
        } else {
            const float b128 = bh[128];
            const int r0 = t - kt * 64 - fq * 4;
#pragma unroll
            for (int nt = 0; nt < 4; ++nt)
#pragma unroll
                for (int j = 0; j < 4; ++j) s[nt][j] = (r0 - (nt * 16 + j) < 512) ? fmaf(s[nt][j], 0.08838834764831845f * LOG2E_, b128) : -1e30f;
            alpha = softmax_step<true>(s, m, l, lane);
        }
#pragma unroll
        for (int i = 0; i < 8; ++i) o[i] *= alpha;
        pv_tile<128, 144>(sb + N_V, fr, fq, s, o);
        if (done2 || mode2 != mode) {
            l += shx(l, lane, 16); l += shx(l, lane, 32);
            const float sc = (mode == 1 ? g1 : g2) / fmaxf(l, 1e-30f);
#pragma unroll
            for (int i = 0; i < 8; ++i) { y[i] += o[i] * sc; o[i] = (f32x4){0.f, 0.f, 0.f, 0.f}; }
            m = -1e30f; l = 0.f;
        }
        if (done2) break;
        __syncthreads();
        cur ^= 1; mode = mode2; kt = kt2; mode2 = mode3; kt2 = kt3; done2 = done3;
    }
    bf16_t* yo = (bf16_t*)(P.ws + O_YA) + row * 1024 + H * 128 + fq * 4;
#pragma unroll
    for (int i = 0; i < 8; ++i) st4(yo + i * 16, y[i]);
}

DI void qk_tile2(const LAS unsigned char* Ks, int fr, int fq, const bf16x8 (&q0)[4], const bf16x8 (&q1)[4], f32x4 (&s0)[4], f32x4 (&s1)[4]) {
    const LAS unsigned char* base = Ks + fr * 272 + fq * 16;
#pragma unroll
    for (int nt = 0; nt < 4; ++nt) {
        bf16x8 kf[4];
#pragma unroll
        for (int kk = 0; kk < 4; ++kk) kf[kk] = *(const LAS bf16x8*)(base + nt * 16 * 272 + kk * 64);
        f32x4 a = (f32x4){0.f, 0.f, 0.f, 0.f}, b = (f32x4){0.f, 0.f, 0.f, 0.f};
#pragma unroll
        for (int kk = 0; kk < 4; ++kk) { a = __builtin_amdgcn_mfma_f32_16x16x32_bf16(kf[kk], q0[kk], a, 0, 0, 0); b = __builtin_amdgcn_mfma_f32_16x16x32_bf16(kf[kk], q1[kk], b, 0, 0, 0); }
        s0[nt] = a; s1[nt] = b;
    }
}
template <int VSTR>
DI void pv_tile2(const LAS unsigned char* Vt, int fr, int fq, const f32x4 (&p0)[4], const f32x4 (&p1)[4], f32x4 (&o0)[8], f32x4 (&o1)[8]) {
    bf16x8 pf0[2], pf1[2];
#pragma unroll
    for (int ks = 0; ks < 2; ++ks) {
        u32x4 a, b;
        a[0] = cvt_pk_bf16(p0[2 * ks][0], p0[2 * ks][1]); a[1] = cvt_pk_bf16(p0[2 * ks][2], p0[2 * ks][3]); a[2] = cvt_pk_bf16(p0[2 * ks + 1][0], p0[2 * ks + 1][1]); a[3] = cvt_pk_bf16(p0[2 * ks + 1][2], p0[2 * ks + 1][3]);
        b[0] = cvt_pk_bf16(p1[2 * ks][0], p1[2 * ks][1]); b[1] = cvt_pk_bf16(p1[2 * ks][2], p1[2 * ks][3]); b[2] = cvt_pk_bf16(p1[2 * ks + 1][0], p1[2 * ks + 1][1]); b[3] = cvt_pk_bf16(p1[2 * ks + 1][2], p1[2 * ks + 1][3]);
        pf0[ks] = __builtin_bit_cast(bf16x8, a); pf1[ks] = __builtin_bit_cast(bf16x8, b);
    }
    const LAS unsigned char* base = Vt + fr * VSTR + fq * 8;
#pragma unroll
    for (int g = 0; g < 4; ++g) {
        bf16x4 lo[2][2], hi[2][2];
#pragma unroll
        for (int d2 = 0; d2 < 2; ++d2)
#pragma unroll
            for (int ks = 0; ks < 2; ++ks) { const LAS unsigned char* q = base + (g * 2 + d2) * 16 * VSTR + ks * 64; lo[d2][ks] = *(const LAS bf16x4*)q; hi[d2][ks] = *(const LAS bf16x4*)(q + 32); }
#pragma unroll
        for (int ks = 0; ks < 2; ++ks)
#pragma unroll
            for (int d2 = 0; d2 < 2; ++d2) {
                const bf16x8 vf = __builtin_shufflevector(lo[d2][ks], hi[d2][ks], 0, 1, 2, 3, 4, 5, 6, 7);
                o0[g * 2 + d2] = __builtin_amdgcn_mfma_f32_16x16x32_bf16(vf, pf0[ks], o0[g * 2 + d2], 0, 0, 0);
                o1[g * 2 + d2] = __builtin_amdgcn_mfma_f32_16x16x32_bf16(vf, pf1[ks], o1[g * 2 + d2], 0, 0, 0);
            }
    }
}
DI f32x4 unpk4(u32x2 w) { f32x4 r; r[0] = __uint_as_float(w.x << 16); r[1] = __uint_as_float(w.x & 0xffff0000u); r[2] = __uint_as_float(w.y << 16); r[3] = __uint_as_float(w.y & 0xffff0000u); return r; }
DI u32x2 pk4(f32x4 v) { u32x2 w; w.x = cvt_pk_bf16(v[0], v[1]); w.y = cvt_pk_bf16(v[2], v[3]); return w; }
DI void nsa_item2(KP& P, LAS unsigned char* lds, int bl, int g, int tt, int wv) {
    const int tid = opq_v(TIDX), wid = tid >> 6, lane = tid & 63, fr = lane & 15, fq = lane >> 4;
    const int hp = wid & 1, ts = wid >> 1, t0 = tt * 64, t = t0 + ts * 16 + fr, bgi = bl * 2 + g, H0 = g * 4 + hp * 2;
    const size_t row = (size_t)bl * 2048 + t;
    constexpr int KST = 17408, VB = 34816, VST = 18432, A2_BIAS = VB + 3 * VST, A2_PART = A2_BIAS + 3136, A2_EDGE = A2_PART + 16384, A2_SELM = A2_EDGE + 16384;
    static_assert(A2_SELM + 256 <= LDS_PHASE, "nsa2 LDS");
    LAS float* bias = (LAS float*)(lds + A2_BIAS);
    LAS float* part = (LAS float*)(lds + A2_PART);
    LAS float* edge = (LAS float*)(lds + A2_EDGE);
    LAS unsigned* selm = (LAS unsigned*)(lds + A2_SELM);
    const bf16_t* ksb = (const bf16_t*)(P.ws + O_KS) + (size_t)bgi * 2048 * 128;
    const bf16_t* kwb = (const bf16_t*)(P.ws + O_KW) + (size_t)bgi * 2048 * 128;
    const bf16_t* vsb = (const bf16_t*)(P.ws + O_VST) + (size_t)bgi * 128 * 2048;
    const bf16_t* vwb = (const bf16_t*)(P.ws + O_VWT) + (size_t)bgi * 128 * 2048;
    u32x4 rk[2], rv[2];
    __syncthreads();
    {
        u32x4 ck[4], cv[4];
        g2r<256, 128>(ck, (const bf16_t*)(P.ws + O_KCMP) + (size_t)bgi * 128 * 128, 128, tid);
        g2r<256, 128>(cv, (const bf16_t*)(P.ws + O_VCMT) + (size_t)bgi * 128 * 128, 128, tid);
        for (int i = tid; i < 4 * 193; i += NT) { const int h4 = i / 193, r = i % 193 - 64; bias[h4 * 196 + r + 64] = r < 0 ? -1e30f : P.in[9][t5_bucket(r) * 8 + g * 4 + h4] * 1.4426950408889634f; }
        r2l<256, 128, 272>(ck, lds, tid);
        r2l<256, 128, 272>(cv, lds + VB, tid);
    }
    bf16x8 q0[4], q1[4];
    { const bf16_t* qp = (const bf16_t*)(P.ws + O_QA) + row * 1024 + H0 * 128 + fq * 8;
#pragma unroll
      for (int kk = 0; kk < 4; ++kk) { q0[kk] = *(const bf16x8*)(qp + kk * 32); q1[kk] = *(const bf16x8*)(qp + 128 + kk * 32); } }
    const float* gt = (const float*)(P.ws + O_GATE) + row * 24 + H0;
    const float g00 = gt[0], g01 = gt[1], g10 = gt[8], g11 = gt[9], g20 = gt[16], g21 = gt[17];
    const LAS float* bh0 = bias + (hp * 2) * 196 + 64;
    const LAS float* bh1 = bh0 + 196;
    bf16_t* yo = (bf16_t*)(P.ws + O_YA) + row * 1024 + H0 * 128 + fq * 4;
    __syncthreads();
#pragma unroll
    for (int hd = 0; hd < 2; ++hd) {
        f32x4 sc[2][4];
        qk_tile<128>(lds, fr, fq, hd ? q1 : q0, sc[0]);
        qk_tile<128>(lds + 64 * 272, fr, fq, hd ? q1 : q0, sc[1]);
        const LAS float* bh = hd ? bh1 : bh0;
        float mx = -1e30f;
#pragma unroll
        for (int kt = 0; kt < 2; ++kt)
#pragma unroll
            for (int nt = 0; nt < 4; ++nt)
#pragma unroll
                for (int j = 0; j < 4; ++j) {
                    const int n = kt * 64 + nt * 16 + fq * 4 + j; int rel = t - 16 * n - 31;
                    rel = rel < -64 ? -64 : (rel > 128 ? 128 : rel);
                    const float v = fmaf(sc[kt][nt][j], 0.08838834764831845f * LOG2E_, bh[rel]);
                    sc[kt][nt][j] = v; mx = fmaxf(mx, v);
                }
        mx = fmaxf(mx, shx(mx, lane, 16)); mx = fmaxf(mx, shx(mx, lane, 32));
        float ls = 0.f;
#pragma unroll
        for (int kt = 0; kt < 2; ++kt)
#pragma unroll
            for (int nt = 0; nt < 4; ++nt)
#pragma unroll
                for (int j = 0; j < 4; ++j) { const float pv = sc[kt][nt][j] > -1e29f ? __builtin_amdgcn_exp2f(sc[kt][nt][j] - mx) : 0.f; sc[kt][nt][j] = pv; ls += pv; }
        ls += shx(ls, lane, 16); ls += shx(ls, lane, 32);
        const float inv = 1.0f / fmaxf(ls, 1e-30f);
#pragma unroll
        for (int kt = 0; kt < 2; ++kt)
#pragma unroll
            for (int nt = 0; nt < 4; ++nt) {
                sc[kt][nt] *= inv;
                const int jidx = kt * 16 + nt * 4 + fq, oo = (hp * 64 + ts * 16 + fr) * 32 + jidx;
                const float ps = (sc[kt][nt][0] + sc[kt][nt][1]) + (sc[kt][nt][2] + sc[kt][nt][3]);
                if (hd == 0) { part[oo] = ps; edge[oo] = sc[kt][nt][3]; } else { part[oo] += ps; edge[oo] += sc[kt][nt][3]; }
            }
        f32x4 oc[8];
#pragma unroll
        for (int i = 0; i < 8; ++i) oc[i] = (f32x4){0.f, 0.f, 0.f, 0.f};
        pv_tile<128, 272>(lds + VB, fr, fq, sc[0], oc);
        pv_tile<128, 272>(lds + VB + 128, fr, fq, sc[1], oc);
        const float gc = hd ? g01 : g00;
#pragma unroll
        for (int i = 0; i < 8; ++i) st4(yo + hd * 128 + i * 16, oc[i] * gc);
    }
    g2r<256, 64>(rk, ksb, 128, tid);
    g2r<128, 128>(rv, vsb, 2048, tid);
    __syncthreads();
#pragma unroll
    for (int pass = 0; pass < 4; ++pass) {
        const int tok = pass * 16 + wid * 2 + (lane >> 5), j = lane & 31;
        float v = 0.f;
#pragma unroll
        for (int h2 = 0; h2 < 2; ++h2) { const int oo = (h2 * 64 + tok) * 32 + j; v += part[oo] + (j > 0 ? edge[oo - 1] : 0.f); }
        const int cur = tt;
        if (j == 0 || (cur - j >= 0 && cur - j < 2)) v = 1e4f;
        if (j > cur) v = -1.0f;
        int rank = 0;
#pragma unroll
        for (int i = 0; i < 32; ++i) { const float vi = shl(v, (lane & 32) + i); rank += (vi > v || (vi == v && i < j)) ? 1 : 0; }
        const unsigned long long bal = __ballot(rank < 16);
        if (j == 0) selm[tok] = (unsigned)((lane & 32) ? (bal >> 32) : (bal & 0xffffffffull));
    }
    __syncthreads();
    unsigned um = selm[lane];
#pragma unroll
    for (int oo = 32; oo > 0; oo >>= 1) um |= (unsigned)__builtin_amdgcn_ds_bpermute((lane ^ oo) << 2, (int)um);
    um = (unsigned)__builtin_amdgcn_readfirstlane((int)um);
    const unsigned mysel = selm[ts * 16 + fr];
    const int kt_hi = tt, kt_lo_w = (t0 - 511) > 0 ? ((t0 - 511) >> 6) : 0;
    um &= (kt_hi >= 31) ? 0xffffffffu : ((2u << kt_hi) - 1u);
    f32x4 o0[8], o1[8];
#pragma unroll
    for (int i = 0; i < 8; ++i) { o0[i] = (f32x4){0.f, 0.f, 0.f, 0.f}; o1[i] = (f32x4){0.f, 0.f, 0.f, 0.f}; }
    float m0 = -1e30f, l0 = 0.f, m1 = -1e30f, l1 = 0.f;
    auto advance = [&](int md, int k, int& md2, int& k2) -> bool {
        md2 = md; k2 = k + 1;
        if (md == 1) {
            const unsigned rem = (k >= 31) ? 0u : (um & ~((2u << k) - 1u));
            if (rem) k2 = __builtin_ctz(rem); else { md2 = 2; k2 = kt_lo_w; }
            return false;
        }
        return k2 > kt_hi;
    };
    const bool grpB = wid >= 4;
    int mode = 1, kt = 0, mode2, kt2, step = 0, pmode = 1; bool plast = false;
    f32x4 s0[4], s1[4];
    r2l<256, 64, 272>(rk, lds, tid);
    r2l<128, 128, 144>(rv, lds + VB, tid);
    bool done2 = advance(mode, kt, mode2, kt2);
    if (!done2) { g2r<256, 64>(rk, (mode2 == 1 ? ksb : kwb) + (size_t)kt2 * 64 * 128, 128, tid); g2r<128, 128>(rv, (mode2 == 1 ? vsb : vwb) + kt2 * 64, 2048, tid); }
    __syncthreads();
    auto finalize = [&](int md) {
        l0 += shx(l0, lane, 16); l0 += shx(l0, lane, 32); l1 += shx(l1, lane, 16); l1 += shx(l1, lane, 32);
        const float c0 = (md == 1 ? g10 : g20) / fmaxf(l0, 1e-30f), c1 = (md == 1 ? g11 : g21) / fmaxf(l1, 1e-30f);
        asm volatile("s_waitcnt vmcnt(0)" ::: "memory");
#pragma unroll
        for (int i = 0; i < 8; ++i) {
            const u32x2 w0 = *(const u32x2*)(yo + i * 16), w1 = *(const u32x2*)(yo + 128 + i * 16);
            st4(yo + i * 16, unpk4(w0) + o0[i] * c0); st4(yo + 128 + i * 16, unpk4(w1) + o1[i] * c1);
            o0[i] = (f32x4){0.f, 0.f, 0.f, 0.f}; o1[i] = (f32x4){0.f, 0.f, 0.f, 0.f};
        }
        m0 = -1e30f; l0 = 0.f; m1 = -1e30f; l1 = 0.f;
    };
    for (;;) {
        const int ks = step & 1, vs = step % 3;
        int mode3 = 0, kt3 = 0; bool done3 = true;
        if (!done2) {
            r2l<256, 64, 272>(rk, lds + (ks ^ 1) * KST, tid);
            r2l<128, 128, 144>(rv, lds + VB + ((step + 1) % 3) * VST, tid);
            done3 = advance(mode2, kt2, mode3, kt3);
            if (!done3) { g2r<256, 64>(rk, (mode3 == 1 ? ksb : kwb) + (size_t)kt3 * 64 * 128, 128, tid); g2r<128, 128>(rv, (mode3 == 1 ? vsb : vwb) + kt3 * 64, 2048, tid); }
        }
        if (grpB && step > 0) {
            pv_tile2<144>(lds + VB + ((step + 2) % 3) * VST, fr, fq, s0, s1, o0, o1);
            if (plast) finalize(pmode);
        }
        qk_tile2(lds + ks * KST, fr, fq, q0, q1, s0, s1);
        const bool selok = mode == 2 || ((mysel >> kt) & 1u) != 0u;
        const bool near = kt * 64 + 191 > t0;
        const bool far = !near && (mode == 1 || (t0 + 63 - kt * 64 < 512));
        float al0, al1;
        if (far) {
            const float b0 = selok ? bh0[128] : -1e30f, b1 = selok ? bh1[128] : -1e30f;
#pragma unroll
            for (int nt = 0; nt < 4; ++nt) { s0[nt] = s0[nt] * (0.08838834764831845f * LOG2E_) + b0; s1[nt] = s1[nt] * (0.08838834764831845f * LOG2E_) + b1; }
            al0 = softmax_step<false>(s0, m0, l0, lane); al1 = softmax_step<false>(s1, m1, l1, lane);
        } else if (near) {
            const int r0 = t - kt * 64 - fq * 4;
#pragma unroll
            for (int nt = 0; nt < 4; ++nt)
#pragma unroll
                for (int j = 0; j < 4; ++j) {
                    int rel = r0 - (nt * 16 + j); rel = rel > 128 ? 128 : rel;
                    const float v0 = fmaf(s0[nt][j], 0.08838834764831845f * LOG2E_, bh0[rel]), v1 = fmaf(s1[nt][j], 0.08838834764831845f * LOG2E_, bh1[rel]);
                    s0[nt][j] = selok ? v0 : -1e30f; s1[nt][j] = selok ? v1 : -1e30f;
                }
            al0 = softmax_step<false>(s0, m0, l0, lane); al1 = softmax_step<false>(s1, m1, l1, lane);
        } else {
            const float b0 = bh0[128], b1 = bh1[128];
            const int r0 = t - kt * 64 - fq * 4;
#pragma unroll
            for (int nt = 0; nt < 4; ++nt)
#pragma unroll
                for (int j = 0; j < 4; ++j) {
                    const bool in = r0 - (nt * 16 + j) < 512;
                    s0[nt][j] = in ? fmaf(s0[nt][j], 0.08838834764831845f * LOG2E_, b0) : -1e30f; s1[nt][j] = in ? fmaf(s1[nt][j], 0.08838834764831845f * LOG2E_, b1) : -1e30f;
                }
            al0 = softmax_step<true>(s0, m0, l0, lane); al1 = softmax_step<true>(s1, m1, l1, lane);
        }
        if (__builtin_amdgcn_ballot_w64(al0 != 1.0f || al1 != 1.0f) != 0ull) {
#pragma unroll
            for (int i = 0; i < 8; ++i) { o0[i] *= al0; o1[i] *= al1; }
        }
        const bool last = done2 || mode2 != mode;
        if (!grpB) {
            pv_tile2<144>(lds + VB + vs * VST, fr, fq, s0, s1, o0, o1);
            if (last) finalize(mode);
        }
        pmode = mode; plast = last;
        if (done2) break;
        __syncthreads();
        ++step; mode = mode2; kt = kt2; mode2 = mode3; kt2 = kt3; done2 = done3;
    }
    if (grpB) { pv_tile2<144>(lds + VB + (step % 3) * VST, fr, fq, s0, s1, o0, o1); finalize(pmode); }
}

DI void ret_item(KP& P, LAS unsigned char* lds, int bl, int h, int qt, int wv) {
    const int tid = opq_v(TIDX), wid = tid >> 6, lane = tid & 63, fr = lane & 15, fq = lane >> 4;
    const int t0 = qt * 128, t = t0 + wid * 16 + fr;
    const size_t row = (size_t)bl * 2048 + t;
    const bf16_t* kb = (const bf16_t*)(P.ws + O_RK) + (size_t)bl * 2048 * 512 + h * 128;
    const bf16_t* vb = (const bf16_t*)(P.ws + O_RVT) + ((size_t)bl * 1024 + h * 256) * 2048;
    u32x4 rk[2], rv[4];
    g2r<256, 64>(rk, kb, 512, tid);
    g2r<128, 256>(rv, vb, 2048, tid);
    bf16x8 qf[4];
    { const bf16_t* qp = (const bf16_t*)(P.ws + O_RQ) + row * 512 + h * 128 + fq * 8;
#pragma unroll
      for (int kk = 0; kk < 4; ++kk) qf[kk] = *(const bf16x8*)(qp + kk * 32); }
    const float lg = log2f(1.0f - exp2f(-5.0f - (float)h));
    f32x4 bdec[4];
#pragma unroll
    for (int nt = 0; nt < 4; ++nt)
#pragma unroll
        for (int j = 0; j < 4; ++j) bdec[nt][j] = exp2f(-(float)(nt * 16 + fq * 4 + j) * lg);
    f32x4 o[16];
#pragma unroll
    for (int i = 0; i < 16; ++i) o[i] = (f32x4){0.f, 0.f, 0.f, 0.f};
    const int kt_hi = (t0 + 127) >> 6;
    __syncthreads();
    r2l<256, 64, 272>(rk, lds + R_K, tid);
    r2l<128, 256, 144>(rv, lds + R_V, tid);
    if (kt_hi >= 1) { g2r<256, 64>(rk, kb + (size_t)64 * 512, 512, tid); g2r<128, 256>(rv, vb + 64, 2048, tid); }
    __syncthreads();
    for (int kt = 0; kt <= kt_hi; ++kt) {
        LAS unsigned char* sb = lds + (kt & 1) * R_STG;
        if (kt < kt_hi) {
            r2l<256, 64, 272>(rk, lds + ((kt + 1) & 1) * R_STG + R_K, tid);
            r2l<128, 256, 144>(rv, lds + ((kt + 1) & 1) * R_STG + R_V, tid);
            if (kt + 1 < kt_hi) { g2r<256, 64>(rk, kb + (size_t)(kt + 2) * 64 * 512, 512, tid); g2r<128, 256>(rv, vb + (kt + 2) * 64, 2048, tid); }
        }
        if (kt * 64 <= t0 + wid * 16 + 15) {
        f32x4 s[4];
        qk_tile<128>(sb + R_K, fr, fq, qf, s);
        const float at = __builtin_amdgcn_exp2f((float)(t - kt * 64) * lg);
        if (kt * 64 + 63 <= t0) {
#pragma unroll
            for (int nt = 0; nt < 4; ++nt) s[nt] *= bdec[nt] * at;
        } else {
#pragma unroll
            for (int nt = 0; nt < 4; ++nt)
#pragma unroll
                for (int j = 0; j < 4; ++j) {
                    const int rel = t - (kt * 64 + nt * 16 + fq * 4 + j);
                    s[nt][j] = rel >= 0 ? s[nt][j] * (bdec[nt][j] * at) : 0.f;
                }
        }
        pv_tile<256, 144>(sb + R_V, fr, fq, s, o);
        }
        __syncthreads();
    }
    float sm = 0.f;
#pragma unroll
    for (int i = 0; i < 16; ++i) sm += (o[i][0] + o[i][1]) + (o[i][2] + o[i][3]);
    sm += shx(sm, lane, 16); sm += shx(sm, lane, 32);
    const float mu = sm * (1.0f / 256.0f);
    float vs = 0.f;
#pragma unroll
    for (int i = 0; i < 16; ++i)
#pragma unroll
        for (int j = 0; j < 4; ++j) { const float d = o[i][j] - mu; vs += d * d; }
    vs += shx(vs, lane, 16); vs += shx(vs, lane, 32);
    const float rs = rsqrtf(vs * (1.0f / 256.0f) + EPS);
    const bf16_t* rg = (const bf16_t*)(P.ws + O_RG) + row * 1024 + h * 256 + fq * 4;
    bf16_t* yo = (bf16_t*)(P.ws + O_YB) + row * 1024 + h * 256 + fq * 4;
#pragma unroll
    for (int i = 0; i < 16; ++i) {
        const bf16x4 gv = *(const bf16x4*)(rg + i * 16);
        f32x4 v;
#pragma unroll
        for (int j = 0; j < 4; ++j) v[j] = (o[i][j] - mu) * rs * bf2f((unsigned short)gv[j]);
        st4(yo + i * 16, v);
    }
}

DI void mem_item(KP& P, LAS unsigned char* lds, int bl, int hm, int qt, int wv) {
    const int tid = opq_v(TIDX), wid = tid >> 6, lane = tid & 63, fr = lane & 15, fq = lane >> 4;
    const size_t row = (size_t)bl * 2048 + qt * 128 + wid * 16 + fr;
    const bf16_t* kb = (const bf16_t*)(P.ws + O_MK) + (size_t)bl * 256 * 1024 + hm * 256;
    const bf16_t* vb = (const bf16_t*)(P.ws + O_MVT) + ((size_t)bl * 1024 + hm * 256) * 256;
    u32x4 rk[4], rv[4];
    g2r<512, 64>(rk, kb, 1024, tid);
    g2r<128, 256>(rv, vb, 256, tid);
    bf16x8 qf[8];
    { const bf16_t* qp = (const bf16_t*)(P.ws + O_MQ) + row * 1024 + hm * 256 + fq * 8;
#pragma unroll
      for (int kk = 0; kk < 8; ++kk) qf[kk] = *(const bf16x8*)(qp + kk * 32); }
    f32x4 o[16];
#pragma unroll
    for (int i = 0; i < 16; ++i) o[i] = (f32x4){0.f, 0.f, 0.f, 0.f};
    float m = -1e30f, l = 0.f;
    constexpr int M_V = 33792, M_STG = M_V + 36864;
    static_assert(2 * M_STG <= LDS_PHASE, "memory attention LDS");
    __syncthreads();
    r2l<512, 64, 528>(rk, lds, tid);
    r2l<128, 256, 144>(rv, lds + M_V, tid);
    g2r<512, 64>(rk, kb + (size_t)64 * 1024, 1024, tid); g2r<128, 256>(rv, vb + 64, 256, tid);
    __syncthreads();
    for (int kt = 0; kt < 4; ++kt) {
        LAS unsigned char* sb = lds + (kt & 1) * M_STG;
        if (kt < 3) {
            r2l<512, 64, 528>(rk, lds + ((kt + 1) & 1) * M_STG, tid);
            r2l<128, 256, 144>(rv, lds + ((kt + 1) & 1) * M_STG + M_V, tid);
            if (kt < 2) { g2r<512, 64>(rk, kb + (size_t)(kt + 2) * 64 * 1024, 1024, tid); g2r<128, 256>(rv, vb + (kt + 2) * 64, 256, tid); }
        }
        f32x4 s[4];
        qk_tile<256>(sb, fr, fq, qf, s);
#pragma unroll
        for (int nt = 0; nt < 4; ++nt) s[nt] *= 0.0625f * LOG2E_;
        const float alpha = softmax_step<false>(s, m, l, lane);
#pragma unroll
        for (int i = 0; i < 16; ++i) o[i] *= alpha;
        pv_tile<256, 144>(sb + M_V, fr, fq, s, o);
        __syncthreads();
    }
    l += shx(l, lane, 16); l += shx(l, lane, 32);
    const float inv = 1.0f / l;
    bf16_t* yo = (bf16_t*)(P.ws + O_YC) + row * 1024 + hm * 256 + fq * 4;
#pragma unroll
    for (int i = 0; i < 16; ++i) st4(yo + i * 16, o[i] * inv);
}

DI void rms_rows(const float* x, const float* g, bf16_t* out, int nrows, int wv) {
    const int tidq = opq_v(TIDX), lane = tidq & 63, gw = opq_s(blockIdx.x) * 8 + (tidq >> 6), nw = gridDim.x * 8;
    for (int r = gw; r < nrows; r += nw) {
        const float* xr = x + (size_t)r * 2048;
        f32x4 v[8]; float ss = 0.f;
#pragma unroll
        for (int i = 0; i < 4; ++i) {
            v[2 * i] = *(const f32x4*)(xr + i * 512 + lane * 8); v[2 * i + 1] = *(const f32x4*)(xr + i * 512 + lane * 8 + 4);
#pragma unroll
            for (int j = 0; j < 4; ++j) ss += v[2 * i][j] * v[2 * i][j] + v[2 * i + 1][j] * v[2 * i + 1][j];
        }
        ss = wave_sum(ss, lane);
        const float rs = rsqrtf(ss * (1.0f / 2048.0f) + EPS);
#pragma unroll
        for (int i = 0; i < 4; ++i) {
            const f32x4 ga = *(const f32x4*)(g + i * 512 + lane * 8), gb = *(const f32x4*)(g + i * 512 + lane * 8 + 4);
            st4(out + (size_t)r * 2048 + i * 512 + lane * 8, v[2 * i] * rs * ga);
            st4(out + (size_t)r * 2048 + i * 512 + lane * 8 + 4, v[2 * i + 1] * rs * gb);
        }
    }
}
template <int MODE>
DI void resid_rows(const float* xf, const bf16_t* xb, const bf16_t* y, const float* g1, const float* g2, float* outf, bf16_t* outb, bf16_t* h2, int nrows, int wv) {
    const int tidq = opq_v(TIDX), lane = tidq & 63, gw = opq_s(blockIdx.x) * 8 + (tidq >> 6), nw = gridDim.x * 8;
    for (int r = gw; r < nrows; r += 2 * nw) {
        const bool two = r + nw < nrows;
        const int rows[2] = {r, two ? r + nw : r};
        bf16x8 yb[2][4]; f32x4 xv[2][8];
#pragma unroll
        for (int rr = 0; rr < 2; ++rr) {
#pragma unroll
            for (int i = 0; i < 4; ++i) yb[rr][i] = *(const bf16x8*)(y + (size_t)rows[rr] * 2048 + i * 512 + lane * 8);
#pragma unroll
            for (int i = 0; i < 4; ++i) {
                if (MODE == 1) { xv[rr][2 * i] = *(const f32x4*)(xf + (size_t)rows[rr] * 2048 + i * 512 + lane * 8); xv[rr][2 * i + 1] = *(const f32x4*)(xf + (size_t)rows[rr] * 2048 + i * 512 + lane * 8 + 4); }
                else { const bf16x8 b = *(const bf16x8*)(xb + (size_t)rows[rr] * 2048 + i * 512 + lane * 8);
#pragma unroll
                    for (int j = 0; j < 4; ++j) { xv[rr][2 * i][j] = bf2f((unsigned short)b[j]); xv[rr][2 * i + 1][j] = bf2f((unsigned short)b[4 + j]); } }
            }
        }
#pragma unroll
        for (int rr = 0; rr < 2; ++rr) {
            if (rr == 1 && !two) break;
            float yv[32]; float ss = 0.f;
#pragma unroll
            for (int i = 0; i < 4; ++i)
#pragma unroll
                for (int j = 0; j < 8; ++j) { const float f = bf2f((unsigned short)yb[rr][i][j]); yv[i * 8 + j] = f; ss += f * f; }
            ss = wave_sum(ss, lane);
            const float rs = rsqrtf(ss * (1.0f / 2048.0f) + EPS);
            float s2 = 0.f;
#pragma unroll
            for (int i = 0; i < 4; ++i) {
                const int c = i * 512 + lane * 8;
                const f32x4 ga = *(const f32x4*)(g1 + c), gb = *(const f32x4*)(g1 + c + 4);
                f32x4 oa, ob;
#pragma unroll
                for (int j = 0; j < 4; ++j) {
                    oa[j] = xv[rr][2 * i][j] + yv[i * 8 + j] * rs * ga[j]; ob[j] = xv[rr][2 * i + 1][j] + yv[i * 8 + 4 + j] * rs * gb[j];
                    yv[i * 8 + j] = oa[j]; yv[i * 8 + 4 + j] = ob[j]; s2 += oa[j] * oa[j] + ob[j] * ob[j];
                }
                if (MODE == 1) *(u32x4*)(outb + (size_t)rows[rr] * 2048 + c) = pk8(oa, ob);
                else { *(f32x4*)(outf + (size_t)rows[rr] * 2048 + c) = oa; *(f32x4*)(outf + (size_t)rows[rr] * 2048 + c + 4) = ob; }
            }
            if (MODE == 1) {
                s2 = wave_sum(s2, lane);
                const float r2 = rsqrtf(s2 * (1.0f / 2048.0f) + EPS);
#pragma unroll
                for (int i = 0; i < 4; ++i) {
                    const int c = i * 512 + lane * 8;
                    const f32x4 ga = *(const f32x4*)(g2 + c), gb = *(const f32x4*)(g2 + c + 4);
                    f32x4 oa, ob;
#pragma unroll
                    for (int j = 0; j < 4; ++j) { oa[j] = yv[i * 8 + j] * r2 * ga[j]; ob[j] = yv[i * 8 + 4 + j] * r2 * gb[j]; }
                    *(u32x4*)(h2 + (size_t)rows[rr] * 2048 + c) = pk8(oa, ob);
                }
            }
        }
    }
}
DI void conv_act(const bf16_t* u, const float* cw, const float* cb, bf16_t* act, int wv) {
    constexpr int CG = DFF / 8, TG = MC / 16;
    const int total = CG * TG;
    for (int task = opq_s(blockIdx.x) * NT + opq_v(TIDX); task < total; task += gridDim.x * NT) {
        const int cgp = task % CG, tg = task / CG, c = cgp * 8, r0 = tg * 16;
        float w[2][3][8], b[2][8];
#pragma unroll
        for (int hv = 0; hv < 2; ++hv) {
#pragma unroll
            for (int k = 0; k < 3; ++k) {
                const f32x4 a0 = *(const f32x4*)(cw + (size_t)k * UPC + hv * DFF + c), a1 = *(const f32x4*)(cw + (size_t)k * UPC + hv * DFF + c + 4);
#pragma unroll
                for (int j = 0; j < 4; ++j) { w[hv][k][j] = a0[j]; w[hv][k][4 + j] = a1[j]; }
            }
            const f32x4 b0 = *(const f32x4*)(cb + hv * DFF + c), b1 = *(const f32x4*)(cb + hv * DFF + c + 4);
#pragma unroll
            for (int j = 0; j < 4; ++j) { b[hv][j] = b0[j]; b[hv][4 + j] = b1[j]; }
        }
        float p2[2][8], p1[2][8];
        const bool first = (r0 & 2047) == 0;
#pragma unroll
        for (int hv = 0; hv < 2; ++hv) {
            bf16x8 a = (bf16x8){0, 0, 0, 0, 0, 0, 0, 0}, bb = a;
            if (!first) { a = *(const bf16x8*)(u + (size_t)(r0 - 2) * UPC + hv * DFF + c); bb = *(const bf16x8*)(u + (size_t)(r0 - 1) * UPC + hv * DFF + c); }
#pragma unroll
            for (int j = 0; j < 8; ++j) { p2[hv][j] = bf2f((unsigned short)a[j]); p1[hv][j] = bf2f((unsigned short)bb[j]); }
        }
#pragma unroll 4
        for (int i = 0; i < 16; ++i) {
            float cv[2][8];
#pragma unroll
            for (int hv = 0; hv < 2; ++hv) {
                const bf16x8 a = *(const bf16x8*)(u + (size_t)(r0 + i) * UPC + hv * DFF + c);
#pragma unroll
                for (int j = 0; j < 8; ++j) {
                    const float x0 = bf2f((unsigned short)a[j]);
                    cv[hv][j] = b[hv][j] + w[hv][0][j] * p2[hv][j] + w[hv][1][j] * p1[hv][j] + w[hv][2][j] * x0;
                    p2[hv][j] = p1[hv][j]; p1[hv][j] = x0;
                }
            }
            f32x4 o0, o1;
#pragma unroll
            for (int j = 0; j < 8; ++j) {
                const float xg = cv[0][j];
                const float z = 0.7978845608028654f * (xg + 0.044715f * xg * xg * xg);
                const float r = xg * sigmoidf_(2.0f * z) * cv[1][j];
                if (j < 4) o0[j] = r; else o1[j - 4] = r;
            }
            st4(act + (size_t)(r0 + i) * DFF + c, o0); st4(act + (size_t)(r0 + i) * DFF + c + 4, o1);
        }
    }
}

DI int win_rowmap(int n) {
    if (n < 2560) return n;
    if (n < 2584) return 12800 + (n - 2560);
    if (n < 3608) {
        const int x = n - 2584, head = x >> 7, o = x & 127, hf = o >> 6, a = (o >> 4) & 3, f = (o >> 2) & 3, j = o & 3;
        return 2560 + head * 128 + 32 * a + 8 * f + 4 * hf + j;
    }
    return n - 24;
}
struct WJob { const float* src; bf16_t* dst; int K, N, k0, n0, mapw; };
constexpr int WT_IN = 32 * 51, WT_UP = 32 * 44, WT_DN = 88 * 8, WT_SQ = 32 * 8, WT_BR = 16 * 8, WT_C1 = 64, WT_C2 = 4;
constexpr int WT_TOTAL = WT_IN + WT_UP + WT_DN + WT_SQ + 3 * WT_BR + WT_SQ + 2 * WT_C1 + 2 * WT_C2;
DI WJob wjob(KP& P, int t) {
    WJob j; int ntn; j.mapw = 0;
    unsigned char* w = P.ws;
    if (t < WT_IN) { j.src = P.in[2]; j.dst = (bf16_t*)(w + O_WIN); j.K = 2048; j.N = IN_COLS; ntn = 51; j.mapw = 1; }
    else if ((t -= WT_IN) < WT_UP) { j.src = P.in[15]; j.dst = (bf16_t*)(w + O_WUP); j.K = 2048; j.N = UPC; ntn = 44; j.mapw = 2; }
    else if ((t -= WT_UP) < WT_DN) { j.src = P.in[18]; j.dst = (bf16_t*)(w + O_WDN); j.K = DFF; j.N = 2048; ntn = 8; }
    else if ((t -= WT_DN) < WT_SQ) { j.src = P.in[14]; j.dst = (bf16_t*)(w + O_WO); j.K = 2048; j.N = 2048; ntn = 8; }
    else if ((t -= WT_SQ) < WT_BR) { j.src = P.in[11]; j.dst = (bf16_t*)(w + O_WBR); j.K = 1024; j.N = 2048; ntn = 8; }
    else if ((t -= WT_BR) < WT_BR) { j.src = P.in[12]; j.dst = (bf16_t*)(w + O_WBR) + (size_t)2048 * 1024; j.K = 1024; j.N = 2048; ntn = 8; }
    else if ((t -= WT_BR) < WT_BR) { j.src = P.in[13]; j.dst = (bf16_t*)(w + O_WBR) + 2 * (size_t)2048 * 1024; j.K = 1024; j.N = 2048; ntn = 8; }
    else if ((t -= WT_BR) < WT_SQ) { j.src = P.in[10]; j.dst = (bf16_t*)(w + O_WMKV); j.K = 2048; j.N = 2048; ntn = 8; }
    else if ((t -= WT_SQ) < WT_C1) { j.src = P.in[4]; j.dst = (bf16_t*)(w + O_WC1); j.K = 4096; j.N = 256; ntn = 1; }
    else if ((t -= WT_C1) < WT_C1) { j.src = P.in[7]; j.dst = (bf16_t*)(w + O_WC1) + (size_t)256 * 4096; j.K = 4096; j.N = 256; ntn = 1; }
    else if ((t -= WT_C1) < WT_C2) { j.src = P.in[5]; j.dst = (bf16_t*)(w + O_WC2); j.K = 256; j.N = 128; ntn = 1; }
    else { t -= WT_C2; j.src = P.in[8]; j.dst = (bf16_t*)(w + O_WC2) + (size_t)256 * 256; j.K = 256; j.N = 128; ntn = 1; }
    j.k0 = (t / ntn) * 64; j.n0 = (t % ntn) * 256;
    return j;
}
DI void wjob_load(const WJob& j, f32x4 (&v)[8], int wv, int lane) {
    const int n = j.n0 + lane * 4;
#pragma unroll
    for (int i = 0; i < 8; ++i) v[i] = n < j.N ? *(const f32x4*)(j.src + (size_t)(j.k0 + wv + 8 * i) * j.N + n) : (f32x4){0.f, 0.f, 0.f, 0.f};
}
DI void zero_fill(unsigned char* p, size_t bytes, int wv) {
    for (size_t i = ((size_t)blockIdx.x * NT + TIDX) * 16; i < bytes; i += (size_t)gridDim.x * NT * 16) *(u32x4*)(p + i) = (u32x4){0u, 0u, 0u, 0u};
}
DI void phase_weights(KP& P, LAS unsigned char* lds, int wv) {
    LAS float* tile = (LAS float*)lds;
    const int lane = lane_now(), tid = wv * 64 + lane;
    zero_fill(P.ws + O_WIN + (size_t)IN_COLS * 2048 * 2, (size_t)(INP - IN_COLS) * 2048 * 2, wv);
    zero_fill(P.ws + O_WC2, 2 * (size_t)256 * 256 * 2, wv);
    for (int pb = blockIdx.x; pb < 256; pb += gridDim.x) {
        const int kv = pb >> 7, sl = pb & 127, jcol = tid & 255, hf = tid >> 8;
        const float* pe = P.in[kv ? 6 : 3]; const float* w1 = P.in[kv ? 7 : 4];
        float a = 0.f;
#pragma unroll
        for (int i = 0; i < 16; ++i) { const int ii = sl * 32 + hf * 16 + i; a += pe[ii] * w1[(size_t)ii * 256 + jcol]; }
        __syncthreads();
        tile[tid] = a;
        __syncthreads();
        if (tid < 256) ((float*)(P.ws + O_PEB + 4096))[(size_t)pb * 256 + tid] = tile[tid] + tile[tid + 256];
    }
    f32x4 v[8];
    int t = blockIdx.x;
    WJob j = wjob(P, t < WT_TOTAL - 2 * WT_C2 ? t : 0);
    if (t < WT_TOTAL - 2 * WT_C2) wjob_load(j, v, wv, lane);
    for (; t < WT_TOTAL - 2 * WT_C2; t += gridDim.x) {
        __syncthreads();
#pragma unroll
        for (int i = 0; i < 8; ++i) *(LAS f32x4*)(tile + (wv + 8 * i) * 260 + lane * 4) = v[i];
        __syncthreads();
        const WJob c = j;
        const int tn = t + gridDim.x;
        if (tn < WT_TOTAL - 2 * WT_C2) { j = wjob(P, tn); wjob_load(j, v, wv, lane); }
#pragma unroll
        for (int i = 0; i < 4; ++i) {
            const int ci = tid + NT * i, nl = ci & 255, kq = ci >> 8, n = c.n0 + nl;
            if (n < c.N) {
                u32x4 w;
#pragma unroll
                for (int e = 0; e < 4; ++e) w[e] = cvt_pk_bf16(tile[(kq * 8 + 2 * e) * 260 + nl], tile[(kq * 8 + 2 * e + 1) * 260 + nl]);
                int dr = n;
                if (c.mapw == 1) dr = win_rowmap(n);
                else if (c.mapw == 2) { const int hv = n >= DFF ? 1 : 0, chn = n - hv * DFF; dr = 256 * (chn >> 7) + 128 * hv + (chn & 127); }
                *(u32x4*)(c.dst + (size_t)dr * c.K + c.k0 + kq * 8) = w;
            }
        }
    }
    __syncthreads();
}
DI void phase_weights2(KP& P, LAS unsigned char* lds, int wv) {
    LAS float* tile = (LAS float*)lds;
    const int lane = lane_now(), tid = wv * 64 + lane;
    for (int q = blockIdx.x; q < 64; q += gridDim.x) {
        const int g = q * 8 + wv, kv = g >> 8, jcol = g & 255;
        const float* pp = (const float*)(P.ws + O_PEB + 4096) + (size_t)kv * 128 * 256 + jcol;
        float s = pp[(size_t)lane * 256] + pp[(size_t)(lane + 64) * 256];
#pragma unroll
        for (int off = 32; off > 0; off >>= 1) s += shx(s, lane, off);
        if (lane == 0) ((float*)(P.ws + O_PEB))[kv * 256 + jcol] = s;
    }
    for (int t = WT_TOTAL - 2 * WT_C2 + blockIdx.x; t < WT_TOTAL; t += gridDim.x) {
        const WJob c = wjob(P, t);
        f32x4 v[8];
        wjob_load(c, v, wv, lane);
        __syncthreads();
#pragma unroll
        for (int i = 0; i < 8; ++i) *(LAS f32x4*)(tile + (wv + 8 * i) * 260 + lane * 4) = v[i];
        __syncthreads();
#pragma unroll
        for (int i = 0; i < 4; ++i) {
            const int ci = tid + NT * i, nl = ci & 255, kq = ci >> 8, n = c.n0 + nl;
            if (n < c.N) {
                u32x4 w;
#pragma unroll
                for (int e = 0; e < 4; ++e) w[e] = cvt_pk_bf16(tile[(kq * 8 + 2 * e) * 260 + nl], tile[(kq * 8 + 2 * e + 1) * 260 + nl]);
                *(u32x4*)(c.dst + (size_t)n * c.K + c.k0 + kq * 8) = w;
            }
        }
    }
    __syncthreads();
}

DI KP* lp(KP* p) { asm volatile("" : "+s"(p)); return p; }
__global__ void __launch_bounds__(NT, 2) fwd_megakernel(Params Parg) {
    extern __shared__ __attribute__((aligned(16))) unsigned char shm[];
    LAS unsigned char* lds = (LAS unsigned char*)shm;
    cg::grid_group grid = cg::this_grid();
    const int wv = __builtin_amdgcn_readfirstlane((int)(threadIdx.x >> 6));
    KP* kp = (KP*)__builtin_amdgcn_kernarg_segment_ptr();
#define P (*lp(kp))
#define WSP (lp(kp)->ws)
    const int G = gridDim.x, bid = blockIdx.x;
    pg8::StaticOrder S;
    LAS unsigned* bst = (LAS unsigned*)(lds + LDS_PHASE);
    if (TIDX == 0) { const unsigned xcc = xcc_id(); bst[0] = xcc; bst[3] = 0u;
        __hip_atomic_fetch_add((unsigned*)(WSP + O_BAR) + 64 * xcc, 1u, __ATOMIC_RELAXED, __HIP_MEMORY_SCOPE_AGENT); }

    phase_weights(P, lds, wv);
    rms_rows(P.in[0], P.in[19], (bf16_t*)(WSP + O_H), MC, wv);
    rms_rows(P.in[1], P.in[21], (bf16_t*)(WSP + O_MEMN), NB * MEML, wv);
    grid.sync();
    if (TIDX == 0) { unsigned nx = 0u; unsigned* w = (unsigned*)(WSP + O_BAR);
      for (int j = 0; j < 16; ++j) nx += __hip_atomic_load(w + 64 * j, __ATOMIC_RELAXED, __HIP_MEMORY_SCOPE_AGENT) != 0u ? 1u : 0u;
      bst[2] = nx; bst[1] = __hip_atomic_load(w + 64 * bst[0], __ATOMIC_RELAXED, __HIP_MEMORY_SCOPE_AGENT); }
    phase_weights2(P, lds, wv);

#pragma nounroll
    for (int ch = 0; ch < NCHUNK; ++ch) {
        const float* xin = P.in[0] + (size_t)ch * MC * DM;
        float* xout = P.out + (size_t)ch * MC * DM;
        { pg8::Gemm g{(const bf16_t*)(WSP + O_H), (const bf16_t*)(WSP + O_WIN), 2048, 2048, MC, INP, 2048};
          S.init(g.M, g.N, G, opq_s(bid)); pg8::gemm_phase(lds, g, S, EpiInProj{WSP}, wv); }
        { pg8::Gemm g{(const bf16_t*)(WSP + O_MEMN), (const bf16_t*)(WSP + O_WMKV), 2048, 2048, NB * MEML, 2048, 2048};
          S.init(g.M, g.N, G, (bid + 64) % G); pg8::gemm_phase(lds, g, S, EpiMemKV{(bf16_t*)(WSP + O_MK), (bf16_t*)(WSP + O_MVT)}, wv); }
        grid_barrier((unsigned*)(WSP + O_BAR), (LAS unsigned*)(lds + LDS_PHASE), wv);
        {
            unsigned* cdone = (unsigned*)(WSP + O_BAR) + 3072 + 64 * (4 + ch);
            unsigned nunits = 0u;
            if (opq_s(bid) < NB * 256 / 256) { pg8::Gemm g{(const bf16_t*)(WSP + O_KC), (const bf16_t*)(WSP + O_WC1), 2048, 4096, NB * 256, 256, 4096};
              S.init(g.M, g.N, G, opq_s(bid));
              pg8::gemm_phase(lds, g, S, EpiC1{(bf16_t*)(WSP + O_H1), (const float*)(WSP + O_PEB)}, wv);
              asm volatile("s_waitcnt vmcnt(0)" ::: "memory"); __syncthreads(); if (TIDX == 0) { __builtin_amdgcn_fence(__ATOMIC_ACQUIRE, "agent"); asm volatile("s_waitcnt vmcnt(0)" ::: "memory"); } __syncthreads();
              pg8::Gemm g2{(const bf16_t*)(WSP + O_H1), (const bf16_t*)(WSP + O_WC2), 256, 256, NB * 256, 256, 256};
              pg8::gemm_phase(lds, g2, S, EpiC2<0>{(bf16_t*)(WSP + O_KCMP)}, wv); }
            if ((opq_s(bid) + 128) % G < NB * 256 / 256) { pg8::Gemm g{(const bf16_t*)(WSP + O_VC), (const bf16_t*)(WSP + O_WC1) + (size_t)256 * 4096, 2048, 4096, NB * 256, 256, 4096};
              S.init(g.M, g.N, G, (bid + 128) % G);
              pg8::gemm_phase(lds, g, S, EpiC1{(bf16_t*)(WSP + O_H1) + (size_t)NB * 256 * 256, (const float*)(WSP + O_PEB) + 256}, wv);
              asm volatile("s_waitcnt vmcnt(0)" ::: "memory"); __syncthreads(); if (TIDX == 0) { __builtin_amdgcn_fence(__ATOMIC_ACQUIRE, "agent"); asm volatile("s_waitcnt vmcnt(0)" ::: "memory"); } __syncthreads();
              pg8::Gemm g2{(const bf16_t*)(WSP + O_H1) + (size_t)NB * 256 * 256, (const bf16_t*)(WSP + O_WC2) + (size_t)256 * 256, 256, 256, NB * 256, 256, 256};
              pg8::gemm_phase(lds, g2, S, EpiC2<1>{(bf16_t*)(WSP + O_VCMT)}, wv); }
            { const int cu = NB * 256 / 256, ck = opq_s(bid), cv = (ck + 128) % G;
              nunits = (ck < cu ? (unsigned)((cu - 1 - ck) / G + 1) : 0u) + (cv < cu ? (unsigned)((cu - 1 - cv) / G + 1) : 0u); }
            if (nunits != 0u) {
                asm volatile("s_waitcnt vmcnt(0)" ::: "memory");
                __syncthreads();
                if (TIDX == 0) { __builtin_amdgcn_fence(__ATOMIC_RELEASE, "agent"); asm volatile("s_waitcnt vmcnt(0)" ::: "memory");
                    __hip_atomic_fetch_add(cdone, nunits, __ATOMIC_RELAXED, __HIP_MEMORY_SCOPE_AGENT); }
            }
            bool nsa_ready = false;
            for (;;) {
                __syncthreads();
                if (TIDX == 0) bst[4] = __hip_atomic_fetch_add((unsigned*)(WSP + O_BAR) + 3072 + 64 * ch, 1u, __ATOMIC_RELAXED, __HIP_MEMORY_SCOPE_AGENT);
                __syncthreads();
                const int i = (int)bst[4];
                if (i >= 2 * NB * 4 * 16 + NB * 2 * 32) break;
                if (i < NB * 4 * 16) { const int bh = i & 31; ret_item(P, lds, bh >> 2, bh & 3, 15 - (i >> 5), wv); }
                else if (i < 2 * NB * 4 * 16) { const int k = i - NB * 4 * 16, bh = k & 31; mem_item(P, lds, bh >> 2, bh & 3, k >> 5, wv); }
                else {
                    if (!nsa_ready) {
                        if (TIDX == 0) { while (__hip_atomic_load(cdone, __ATOMIC_RELAXED, __HIP_MEMORY_SCOPE_AGENT) < 2u * (NB * 256 / 256)) __builtin_amdgcn_s_sleep(2);
                            __builtin_amdgcn_fence(__ATOMIC_ACQUIRE, "agent"); asm volatile("s_waitcnt vmcnt(0)" ::: "memory"); }
                        __syncthreads();
                        nsa_ready = true;
                    }
                    const int k = i - 2 * NB * 4 * 16, bgi = k & 15;
                    nsa_item2(P, lds, bgi >> 1, bgi & 1, 31 - (k >> 4), wv);
                }
            }
        }
        grid_barrier((unsigned*)(WSP + O_BAR), (LAS unsigned*)(lds + LDS_PHASE), wv);
        { pg8::Gemm g{(const bf16_t*)(WSP + O_YA), (const bf16_t*)(WSP + O_WBR), 1024, 1024, MC, 2048, 1024};
          S.init(g.M, g.N, G, opq_s(bid)); pg8::gemm_phase(lds, g, S, EpiMerge<1>{(bf16_t*)(WSP + O_H), (const bf16_t*)(WSP + O_BG), 0}, wv);
          g.A = (const bf16_t*)(WSP + O_YB); g.Bt = (const bf16_t*)(WSP + O_WBR) + (size_t)2048 * 1024;
          pg8::gemm_phase(lds, g, S, EpiMerge<0>{(bf16_t*)(WSP + O_H), (const bf16_t*)(WSP + O_BG), 2048}, wv);
          g.A = (const bf16_t*)(WSP + O_YC); g.Bt = (const bf16_t*)(WSP + O_WBR) + 2 * (size_t)2048 * 1024;
          pg8::gemm_phase(lds, g, S, EpiMerge<0>{(bf16_t*)(WSP + O_H), (const bf16_t*)(WSP + O_BG), 4096}, wv); }
        grid_barrier((unsigned*)(WSP + O_BAR), (LAS unsigned*)(lds + LDS_PHASE), wv);
        { pg8::Gemm g{(const bf16_t*)(WSP + O_H), (const bf16_t*)(WSP + O_WO), 2048, 2048, MC, 2048, 2048};
          S.init(g.M, g.N, G, opq_s(bid)); pg8::gemm_phase(lds, g, S, EpiStore{(bf16_t*)(WSP + O_MO), 2048}, wv); }
        grid_barrier((unsigned*)(WSP + O_BAR), (LAS unsigned*)(lds + LDS_PHASE), wv);
        resid_rows<1>(xin, nullptr, (const bf16_t*)(WSP + O_MO), P.in[20], P.in[22], nullptr, (bf16_t*)(WSP + O_YA), (bf16_t*)(WSP + O_H), MC, wv);
        grid_barrier((unsigned*)(WSP + O_BAR), (LAS unsigned*)(lds + LDS_PHASE), wv);
        { pg8::Gemm g{(const bf16_t*)(WSP + O_H), (const bf16_t*)(WSP + O_WUP), 2048, 2048, MC, UPC, 2048};
          S.init(g.M, g.N, G, opq_s(bid)); pg8::gemm_phase(lds, g, S, EpiUpConv{(bf16_t*)(WSP + O_ACT), P.in[16], P.in[17], (float*)(WSP + O_HU), (float*)(WSP + O_HF), (LAS float*)(lds + LDS_HALO)}, wv); }
        grid_barrier((unsigned*)(WSP + O_BAR), (LAS unsigned*)(lds + LDS_PHASE), wv);
        conv_fixup((const float*)(WSP + O_HU), (const float*)(WSP + O_HF), P.in[16], P.in[17], (bf16_t*)(WSP + O_ACT), wv);
        grid_barrier((unsigned*)(WSP + O_BAR), (LAS unsigned*)(lds + LDS_PHASE), wv);
        { pg8::Gemm g{(const bf16_t*)(WSP + O_ACT), (const bf16_t*)(WSP + O_WDN), DFF, DFF, MC, 2048, DFF};
          S.init(g.M, g.N, G, opq_s(bid)); pg8::gemm_phase(lds, g, S, EpiStore{(bf16_t*)(WSP + O_MO), 2048}, wv); }
        grid_barrier((unsigned*)(WSP + O_BAR), (LAS unsigned*)(lds + LDS_PHASE), wv);
        resid_rows<0>(nullptr, (const bf16_t*)(WSP + O_YA), (const bf16_t*)(WSP + O_MO), P.in[23], nullptr, xout, nullptr, nullptr, MC, wv);
        if (ch + 1 < NCHUNK) {
            rms_rows(P.in[0] + (size_t)(ch + 1) * MC * DM, P.in[19], (bf16_t*)(WSP + O_H), MC, wv);
            rms_rows(P.in[1] + (size_t)(ch + 1) * NB * MEML * DM, P.in[21], (bf16_t*)(WSP + O_MEMN), NB * MEML, wv);
            grid_barrier((unsigned*)(WSP + O_BAR), (LAS unsigned*)(lds + LDS_PHASE), wv);
        }
    }
}

#undef P
#undef WSP
extern "C" void kernel_launch(void* const* d_in, const int* in_sizes, int n_in, void* d_out, int out_size, void* d_ws, size_t ws_size, hipStream_t stream) {
    static int grid_blocks = 0;
    if (grid_blocks == 0) {
        if (n_in != 24 || ws_size < O_END) { fprintf(stderr, "kernel_launch: unexpected inputs (n_in %d, ws %zu, need %zu)\n", n_in, ws_size, (size_t)O_END); grid_blocks = -1; return; }
        int dev = 0, cus = 0, per_cu = 0;
        hipGetDevice(&dev);
        hipDeviceGetAttribute(&cus, hipDeviceAttributeMultiprocessorCount, dev);
        if (hipFuncSetAttribute((const void*)fwd_megakernel, hipFuncAttributeMaxDynamicSharedMemorySize, LDS_BYTES) != hipSuccess) { fprintf(stderr, "kernel_launch: hipFuncSetAttribute failed\n"); grid_blocks = -1; return; }
        if (hipOccupancyMaxActiveBlocksPerMultiprocessor(&per_cu, (const void*)fwd_megakernel, NT, LDS_BYTES) != hipSuccess || per_cu < 1) { fprintf(stderr, "kernel_launch: occupancy query failed (%d)\n", per_cu); per_cu = 1; (void)hipGetLastError(); }
        grid_blocks = cus * 1;
    }
    if (grid_blocks < 0) return;
    Params p{};
    for (int i = 0; i < 24; ++i) p.in[i] = (const float*)d_in[i];
    p.out = (float*)d_out; p.ws = (unsigned char*)d_ws;
    if (hipMemsetAsync((unsigned char*)d_ws + O_BAR, 0, 16384, stream) != hipSuccess) { fprintf(stderr, "kernel_launch: memset failed\n"); return; }
    void* args[] = {&p};
    hipError_t e = hipLaunchCooperativeKernel((const void*)fwd_megakernel, dim3(grid_blocks), dim3(NT), args, LDS_BYTES, stream);
    if (e != hipSuccess) fprintf(stderr, "cooperative launch failed: %s (grid %d)\n", hipGetErrorString(e), grid_blocks);
}
```
